# Optimizing an MI355X kernel written in HIP

```python
import math
import jax, jax.numpy as jnp
from jax import lax
import numpy as np

D_MODEL = 1024
BATCH = 2
SEQ = 16384
DEPTH = 1
DEC_BATCH = 32
DEC_SEQ = 16
PAST_LEN = 1024

CHUNK = 64
N_META = 16
N_HEADS = 8
HEAD_DIM = 64
D_ATT = N_HEADS * HEAD_DIM
SSM_GROUP = 16
D_SSM = 512
N_SSM_GROUPS = D_SSM // SSM_GROUP
SSM_STATE = 64
D_MIX = D_ATT + D_SSM
Q_BLOCK = 128
EPS = 1e-6
NEG_INF = -1e30
D_IN = 3 * D_ATT + N_HEADS + D_ATT + 2 * D_SSM
SPLITS = (D_ATT, 2 * D_ATT, 3 * D_ATT, 3 * D_ATT + N_HEADS, 4 * D_ATT + N_HEADS,
          4 * D_ATT + N_HEADS + D_SSM)

kernel_name = 'hymba_fox_s5_streaming_step'


def rms_norm(x, g):
    xf = x.astype(jnp.float32)
    y = xf * lax.rsqrt(jnp.mean(xf * xf, axis=-1, keepdims=True) + EPS)
    return (y * g.astype(jnp.float32)).astype(x.dtype)


def mixer_inputs(x, norm_g, w_in, b_f, q_norm_g, k_norm_g):
    bsz, L = x.shape[0], x.shape[1]
    z = rms_norm(x, norm_g) @ w_in
    q, k, v, f_logit, gate_a, u, gate_s = jnp.split(z, SPLITS, axis=-1)
    q = rms_norm(q.reshape(bsz, L, N_HEADS, HEAD_DIM), q_norm_g)
    k = rms_norm(k.reshape(bsz, L, N_HEADS, HEAD_DIM), k_norm_g)
    v = v.reshape(bsz, L, N_HEADS, HEAD_DIM)
    logf = jax.nn.log_sigmoid(f_logit.astype(jnp.float32) + b_f.astype(jnp.float32))
    u = u.reshape(bsz, L, N_SSM_GROUPS, SSM_GROUP)
    return q, k, v, logf, gate_a, u, gate_s


def fox_attend(q, k, v, cum_q, cum_k, q_pos):
    s = jnp.einsum('bthd,bshd->bhts', q, k, preferred_element_type=jnp.float32) * (HEAD_DIM ** -0.5)
    bias = jnp.swapaxes(cum_q, 1, 2)[:, :, :, None] - jnp.swapaxes(cum_k, 1, 2)[:, :, None, :]
    mask = jnp.arange(k.shape[1])[None, :] <= q_pos[:, None]
    p = jax.nn.softmax(jnp.where(mask, s + bias, NEG_INF), axis=-1)
    return jnp.einsum('bhts,bshd->bthd', p.astype(v.dtype), v)


def fox_prompt(q, k, v, logf):
    bsz, L = q.shape[0], q.shape[1]
    n_blk = -(-L // Q_BLOCK)
    pad = n_blk * Q_BLOCK - L
    cum = jnp.cumsum(logf, axis=1)
    q_p = jnp.pad(q, ((0, 0), (0, pad), (0, 0), (0, 0)))
    cum_p = jnp.pad(cum, ((0, 0), (0, pad), (0, 0)))

    def one_block(i):
        start = i * Q_BLOCK
        qb = lax.dynamic_slice_in_dim(q_p, start, Q_BLOCK, axis=1)
        cb = lax.dynamic_slice_in_dim(cum_p, start, Q_BLOCK, axis=1)
        return fox_attend(qb, k, v, cb, cum, start + jnp.arange(Q_BLOCK))

    out = lax.map(one_block, jnp.arange(n_blk))
    out = jnp.moveaxis(out, 0, 1).reshape(bsz, n_blk * Q_BLOCK, N_HEADS, HEAD_DIM)
    return out[:, :L]


def fox_sample(q, k, v, logf, cache_k, cache_v, cache_logf):
    past = cache_k.shape[1]
    T = q.shape[1]
    k_all = jnp.concatenate([cache_k.astype(k.dtype), k], axis=1)
    v_all = jnp.concatenate([cache_v.astype(v.dtype), v], axis=1)
    cum = jnp.cumsum(jnp.concatenate([cache_logf.astype(jnp.float32), logf], axis=1), axis=1)
    return fox_attend(q, k_all, v_all, cum[:, past:], cum, past + jnp.arange(T))


def s5_scan(u, x0, a_re, a_im, log_dt, b_re, b_im, c_re, c_im, d):
    f32 = jnp.float32
    A = lax.complex(a_re.astype(f32), a_im.astype(f32))
    dt = jnp.exp(log_dt.astype(f32))[:, None]
    a_bar = jnp.exp(A * dt)
    b_bar = ((a_bar - 1.0) / A)[..., None] * lax.complex(b_re.astype(f32), b_im.astype(f32))
    c = lax.complex(c_re.astype(f32), c_im.astype(f32))
    uf = u.astype(f32)
    bu = jnp.einsum('gph,blgh->blgp', b_bar, uf)
    a_seq = jnp.broadcast_to(a_bar, bu.shape)

    def combine(left, right):
        a1, b1 = left
        a2, b2 = right
        return a2 * a1, a2 * b1 + b2

    a_cum, xs = lax.associative_scan(combine, (a_seq, bu), axis=1)
    xs = xs + a_cum * x0[:, None]
    y = jnp.einsum('ghp,blgp->blgh', c, xs).real + d.astype(f32) * uf
    return y, xs[:, -1]


def mixer_output(att, gate_a, ys, gate_s, w_glu, b_glu, w_out):
    bsz, L = att.shape[0], att.shape[1]
    att = att.reshape(bsz, L, D_ATT) * jax.nn.silu(gate_a)
    z = jax.nn.gelu(ys.reshape(bsz, L, D_SSM)).astype(gate_s.dtype)
    s5 = z * jax.nn.sigmoid(z @ w_glu + b_glu) * jax.nn.silu(gate_s)
    return jnp.concatenate([att, s5], axis=-1) @ w_out


def setup_inputs(seed: int = 0) -> dict:
    key = jax.random.key(seed)
    ks = jax.random.split(key, 24)
    f32 = jnp.float32

    def nrm(k, shape, s):
        return s * jax.random.normal(k, shape, f32)

    G, P = N_SSM_GROUPS, SSM_STATE
    return {
        'x_prompt': nrm(ks[0], (BATCH, SEQ, D_MODEL), 1.0),
        'x_sample': nrm(ks[1], (DEC_BATCH, DEC_SEQ, D_MODEL), 1.0),
        'cache_k': nrm(ks[2], (DEPTH, DEC_BATCH, PAST_LEN, N_HEADS, HEAD_DIM), 1.0),
        'cache_v': nrm(ks[3], (DEPTH, DEC_BATCH, PAST_LEN, N_HEADS, HEAD_DIM), 1.0),
        'cache_logf': jax.nn.log_sigmoid(2.5 + jax.random.normal(ks[4], (DEPTH, DEC_BATCH, PAST_LEN, N_HEADS), f32)),
        'state_s5_re': nrm(ks[5], (DEPTH, DEC_BATCH, G, P), 0.1),
        'state_s5_im': nrm(ks[6], (DEPTH, DEC_BATCH, G, P), 0.1),
        'meta_tokens': nrm(ks[7], (N_META, D_MODEL), 1.0),
        'norm_g': 1.0 + nrm(ks[8], (DEPTH, D_MODEL), 0.02),
        'w_in': nrm(ks[9], (DEPTH, D_MODEL, D_IN), D_MODEL ** -0.5),
        'b_f': jax.random.uniform(ks[10], (DEPTH, N_HEADS), f32, 1.0, 4.0),
        'q_norm_g': 1.0 + nrm(ks[11], (DEPTH, HEAD_DIM), 0.02),
        'k_norm_g': 1.0 + nrm(ks[12], (DEPTH, HEAD_DIM), 0.02),
        's5_a_re': -0.5 + nrm(ks[13], (DEPTH, G, P), 0.01),
        's5_a_im': math.pi * jnp.arange(P, dtype=f32) + nrm(ks[14], (DEPTH, G, P), 0.01),
        's5_log_dt': jax.random.uniform(ks[15], (DEPTH, G), f32, math.log(1e-3), math.log(1e-1)),
        's5_b_re': nrm(ks[16], (DEPTH, G, P, SSM_GROUP), (2 * SSM_GROUP) ** -0.5),
        's5_b_im': nrm(ks[17], (DEPTH, G, P, SSM_GROUP), (2 * SSM_GROUP) ** -0.5),
        's5_c_re': nrm(ks[18], (DEPTH, G, SSM_GROUP, P), (2 * P) ** -0.5),
        's5_c_im': nrm(ks[19], (DEPTH, G, SSM_GROUP, P), (2 * P) ** -0.5),
        's5_d': nrm(ks[20], (DEPTH, G, SSM_GROUP), 1.0),
        'w_glu': nrm(ks[21], (DEPTH, D_SSM, D_SSM), D_SSM ** -0.5),
        'b_glu': nrm(ks[22], (DEPTH, D_SSM), 0.01),
        'w_out': nrm(ks[23], (DEPTH, D_MIX, D_MODEL), D_MIX ** -0.5),
    }


def reference(x_prompt, x_sample, cache_k, cache_v, cache_logf, state_s5_re, state_s5_im,
              meta_tokens, norm_g, w_in, b_f, q_norm_g, k_norm_g, s5_a_re, s5_a_im, s5_log_dt,
              s5_b_re, s5_b_im, s5_c_re, s5_c_im, s5_d, w_glu, b_glu, w_out):
    bp = x_prompt.shape[0]
    meta = jnp.broadcast_to(meta_tokens.astype(x_prompt.dtype)[None], (bp, N_META, D_MODEL))
    hp = jnp.concatenate([meta, x_prompt], axis=1)
    hs = x_sample
    kp, vp, fp, srp, sip = [], [], [], [], []
    kss, vss, fss, srs, sis = [], [], [], [], []
    for l in range(DEPTH):
        proj = (norm_g[l], w_in[l], b_f[l], q_norm_g[l], k_norm_g[l])
        ssm = (s5_a_re[l], s5_a_im[l], s5_log_dt[l], s5_b_re[l], s5_b_im[l],
               s5_c_re[l], s5_c_im[l], s5_d[l])
        outp = (w_glu[l], b_glu[l], w_out[l])

        q, k, v, logf, ga, u, gs = mixer_inputs(hp, *proj)
        att = fox_prompt(q, k, v, logf)
        x0 = jnp.zeros((bp, N_SSM_GROUPS, SSM_STATE), jnp.complex64)
        ys, xl = s5_scan(u, x0, *ssm)
        hp = hp + mixer_output(att, ga, ys, gs, *outp)
        kp.append(k); vp.append(v); fp.append(logf)
        srp.append(xl.real); sip.append(xl.imag)

        q, k, v, logf, ga, u, gs = mixer_inputs(hs, *proj)
        att = fox_sample(q, k, v, logf, cache_k[l], cache_v[l], cache_logf[l])
        x0 = lax.complex(state_s5_re[l].astype(jnp.float32), state_s5_im[l].astype(jnp.float32))
        ys, xl = s5_scan(u, x0, *ssm)
        hs = hs + mixer_output(att, ga, ys, gs, *outp)
        kss.append(k); vss.append(v); fss.append(logf)
        srs.append(xl.real); sis.append(xl.imag)

    y_prompt = hp[:, N_META:]
    y_sample = hs
    new_k_prompt = jnp.stack(kp)
    new_v_prompt = jnp.stack(vp)
    new_logf_prompt = jnp.stack(fp)
    new_s5_re_prompt = jnp.stack(srp)
    new_s5_im_prompt = jnp.stack(sip)
    new_k_sample = jnp.stack(kss)
    new_v_sample = jnp.stack(vss)
    new_logf_sample = jnp.stack(fss)
    new_s5_re_sample = jnp.stack(srs)
    new_s5_im_sample = jnp.stack(sis)
    return (y_prompt, y_sample, new_k_prompt, new_v_prompt, new_logf_prompt,
            new_s5_re_prompt, new_s5_im_prompt, new_k_sample, new_v_sample,
            new_logf_sample, new_s5_re_sample, new_s5_im_sample)
```

```cpp
#include <hip/hip_runtime.h>
#include <stdint.h>
#include <cstdio>

typedef _Float16 h16;
typedef _Float16 h16x8 __attribute__((ext_vector_type(8)));
typedef _Float16 h16x4 __attribute__((ext_vector_type(4)));
typedef float f32x4 __attribute__((ext_vector_type(4)));

constexpr int DM = 1024, NB = 2, SEQ = 16384, NMETA = 16, LSEQ = SEQ + NMETA, DB = 32, DS = 16, PAST = 1024;
constexpr int NH = 8, HD = 64, DATT = 512, DSSM = 512, NG = 32, SG = 16, NST = 64, DIN = 3080;
constexpr int PADF = 240, LP = 16640;
constexpr int MP = NB * LP;
constexpr int MS = DB * DS;
constexpr int MT = MP + MS;
constexpr int NCH = LP / 64;
constexpr float EPS = 1e-6f;

constexpr size_t O_YP = 0;
constexpr size_t O_YS = O_YP + (size_t)NB * SEQ * DM;
constexpr size_t O_KP = O_YS + (size_t)DB * DS * DM;
constexpr size_t O_VP = O_KP + (size_t)NB * LSEQ * DATT;
constexpr size_t O_FP = O_VP + (size_t)NB * LSEQ * DATT;
constexpr size_t O_SRP = O_FP + (size_t)NB * LSEQ * NH;
constexpr size_t O_SIP = O_SRP + (size_t)NB * NG * NST;
constexpr size_t O_KS = O_SIP + (size_t)NB * NG * NST;
constexpr size_t O_VS = O_KS + (size_t)DB * DS * DATT;
constexpr size_t O_FS = O_VS + (size_t)DB * DS * DATT;
constexpr size_t O_SRS = O_FS + (size_t)DB * DS * NH;
constexpr size_t O_SIS = O_SRS + (size_t)DB * NG * NST;
constexpr size_t O_END = O_SIS + (size_t)DB * NG * NST;

constexpr size_t al256(size_t x) { return (x + 255) & ~(size_t)255; }
constexpr size_t WS_WINT = 0;
constexpr size_t WS_WGLUT = al256(WS_WINT + (size_t)3072 * 1024 * 2);
constexpr size_t WS_WOUTT = al256(WS_WGLUT + (size_t)512 * 512 * 2);
constexpr size_t WS_XN = al256(WS_WOUTT + (size_t)1024 * 1024 * 2);
constexpr size_t WS_LOGF = al256(WS_XN + (size_t)MT * 1024 * 2);
constexpr size_t WS_CUM = al256(WS_LOGF + (size_t)MT * 8 * 4);
constexpr size_t WS_CUMS = al256(WS_CUM + (size_t)MT * 8 * 8);
constexpr size_t WS_ZQK = al256(WS_CUMS + (size_t)DB * 1040 * 8 * 8);
constexpr size_t WS_GA = al256(WS_ZQK + (size_t)MT * 1024 * 4);
constexpr size_t WS_U = al256(WS_GA + (size_t)MT * 512 * 2);
constexpr size_t WS_GS = al256(WS_U + (size_t)MT * 512 * 2);
constexpr size_t WS_Z = al256(WS_GS + (size_t)MT * 512 * 2);
constexpr size_t WS_MIX = al256(WS_Z + (size_t)MT * 512 * 2);
constexpr size_t WS_ABAR = al256(WS_MIX + (size_t)MT * 1024 * 2);
constexpr size_t WS_BBAR = al256(WS_ABAR + (size_t)3 * NG * NST * 8);
constexpr size_t WS_SEND = al256(WS_BBAR + (size_t)NG * NST * SG * 8);
constexpr size_t WS_XST = al256(WS_SEND + (size_t)NB * NCH * NG * NST * 8);
constexpr size_t WS_END = al256(WS_XST + (size_t)NB * NCH * NG * NST * 8);

__device__ __forceinline__ float wave_sum(float v) {
#pragma unroll
    for (int o = 32; o > 0; o >>= 1) v += __shfl_xor(v, o);
    return v;
}
__device__ __forceinline__ float sigmoidf_(float x) { return 1.0f / (1.0f + __expf(-x)); }
__device__ __forceinline__ float siluf_(float x) { return x * sigmoidf_(x); }
__device__ __forceinline__ float gelu_tanh(float y) { return 0.5f * y * (1.0f + tanhf(0.7978845608028654f * (y + 0.044715f * y * y * y))); }

template <int MODE>
__global__ __launch_bounds__(256) void k_transpose(const float* __restrict__ W, int K, int ldw, h16* __restrict__ out) {
    __shared__ float t[64][65];
    const int tid = threadIdx.x, n0 = blockIdx.x * 64, k0 = blockIdx.y * 64;
    const int c0 = (MODE == 1 && n0 >= 1536) ? n0 + 8 : n0;
#pragma unroll
    for (int i = 0; i < 16; ++i) { const int kk = i * 4 + (tid >> 6), nn = tid & 63; t[kk][nn] = W[(size_t)(k0 + kk) * ldw + c0 + nn]; }
    __syncthreads();
#pragma unroll
    for (int i = 0; i < 16; ++i) { const int nn = i * 4 + (tid >> 6), kk = tid & 63; out[(size_t)(n0 + nn) * K + k0 + kk] = (h16)t[kk][nn]; }
}

__global__ __launch_bounds__(256) void k_rownorm(const float* __restrict__ xp, const float* __restrict__ xs, const float* __restrict__ meta,
                                                 const float* __restrict__ g, const float* __restrict__ win, const float* __restrict__ bf,
                                                 h16* __restrict__ XN, float* __restrict__ LOGF, float* __restrict__ out) {
    __shared__ float wf[8 * 1024];
    const int tid = threadIdx.x, lane = tid & 63, wave = tid >> 6;
    for (int i = tid; i < 8192; i += 256) { const int k = i >> 3, h = i & 7; wf[h * 1024 + k] = win[(size_t)k * DIN + 1536 + h]; }
    __syncthreads();
    for (int R = blockIdx.x * 4 + wave; R < MT; R += gridDim.x * 4) {
        const float* src = nullptr; float* olf = nullptr;
        if (R < MP) { const int b = R / LP, i = R % LP, t = i - PADF;
            if (t >= 0) { src = (t < NMETA) ? meta + (size_t)t * DM : xp + ((size_t)b * SEQ + (t - NMETA)) * DM; olf = out + O_FP + ((size_t)b * LSEQ + t) * NH; } }
        else { const int r = R - MP; src = xs + (size_t)r * DM; olf = out + O_FS + (size_t)r * NH; }
        uint2* xo = (uint2*)(XN + (size_t)R * DM);
        if (!src) {
#pragma unroll
            for (int j = 0; j < 4; ++j) xo[lane + 64 * j] = make_uint2(0u, 0u);
            if (lane < 8) LOGF[(size_t)R * 8 + lane] = 0.f;
            continue;
        }
        float4 v[4]; float ss = 0.f;
#pragma unroll
        for (int j = 0; j < 4; ++j) { v[j] = ((const float4*)src)[lane + 64 * j]; ss += v[j].x * v[j].x + v[j].y * v[j].y + v[j].z * v[j].z + v[j].w * v[j].w; }
        ss = wave_sum(ss);
        const float rstd = 1.0f / sqrtf(ss * (1.0f / DM) + EPS);
        float fl[8];
#pragma unroll
        for (int h = 0; h < 8; ++h) fl[h] = 0.f;
#pragma unroll
        for (int j = 0; j < 4; ++j) {
            const float4 gv = ((const float4*)g)[lane + 64 * j];
            v[j].x *= rstd * gv.x; v[j].y *= rstd * gv.y; v[j].z *= rstd * gv.z; v[j].w *= rstd * gv.w;
            h16x4 o = {(h16)v[j].x, (h16)v[j].y, (h16)v[j].z, (h16)v[j].w};
            xo[lane + 64 * j] = __builtin_bit_cast(uint2, o);
#pragma unroll
            for (int h = 0; h < 8; ++h) { const float4 w = *(const float4*)&wf[h * 1024 + 4 * (lane + 64 * j)]; fl[h] += v[j].x * w.x + v[j].y * w.y + v[j].z * w.z + v[j].w * w.w; }
        }
        float mine = 0.f;
#pragma unroll
        for (int h = 0; h < 8; ++h) { const float s = wave_sum(fl[h]); if (lane == h) mine = s; }
        if (lane < 8) {
            const float x = mine + bf[lane];
            const float lf = fminf(x, 0.f) - log1pf(expf(-fabsf(x)));
            LOGF[(size_t)R * 8 + lane] = lf; olf[lane] = lf;
        }
    }
}

__global__ __launch_bounds__(256) void k_cum_prompt(const float* __restrict__ LOGF, double* __restrict__ CUM) {
    __shared__ double part[256];
    const int h = blockIdx.x, b = blockIdx.y, tid = threadIdx.x;
    const int per = LP / 256;
    const size_t base = (size_t)b * LP + (size_t)tid * per;
    double s = 0.0;
    for (int i = 0; i < per; ++i) s += (double)LOGF[(base + i) * 8 + h];
    part[tid] = s; __syncthreads();
    if (tid == 0) { double r = 0.0; for (int i = 0; i < 256; ++i) { const double t = part[i]; part[i] = r; r += t; } }
    __syncthreads();
    double r = part[tid];
    for (int i = 0; i < per; ++i) { r += (double)LOGF[(base + i) * 8 + h]; CUM[(base + i) * 8 + h] = r; }
}
__global__ __launch_bounds__(64) void k_cum_sample(const float* __restrict__ LOGF, const float* __restrict__ clf, double* __restrict__ CUMS) {
    const int h = blockIdx.x, sb = blockIdx.y;
    if (threadIdx.x != 0) return;
    double r = 0.0;
    for (int s = 0; s < PAST + DS; ++s) {
        const float v = (s < PAST) ? clf[((size_t)sb * PAST + s) * NH + h] : LOGF[((size_t)MP + sb * DS + (s - PAST)) * 8 + h];
        r += (double)v; CUMS[((size_t)sb * (PAST + DS) + s) * 8 + h] = r;
    }
}

template <class Epi>
__global__ __launch_bounds__(256) void k_gemm(const h16* __restrict__ A, const h16* __restrict__ Bt, int K, Epi E) {
    const int tid = threadIdx.x, lane = tid & 63, wave = tid >> 6, wr = wave >> 1, wc = wave & 1;
    const int m0 = blockIdx.y * 128 + wr * 64, n0 = blockIdx.x * 128 + wc * 64;
    f32x4 acc[4][4];
#pragma unroll
    for (int i = 0; i < 4; ++i)
#pragma unroll
        for (int j = 0; j < 4; ++j) acc[i][j] = (f32x4){0.f, 0.f, 0.f, 0.f};
    const h16* ap = A + (size_t)(m0 + (lane & 15)) * K + 8 * (lane >> 4);
    const h16* bp = Bt + (size_t)(n0 + (lane & 15)) * K + 8 * (lane >> 4);
    for (int k0 = 0; k0 < K; k0 += 32) {
        h16x8 a[4], b[4];
#pragma unroll
        for (int i = 0; i < 4; ++i) a[i] = *(const h16x8*)(ap + (size_t)i * 16 * K + k0);
#pragma unroll
        for (int j = 0; j < 4; ++j) b[j] = *(const h16x8*)(bp + (size_t)j * 16 * K + k0);
#pragma unroll
        for (int i = 0; i < 4; ++i)
#pragma unroll
            for (int j = 0; j < 4; ++j) acc[i][j] = __builtin_amdgcn_mfma_f32_16x16x32_f16(a[i], b[j], acc[i][j], 0, 0, 0);
    }
#pragma unroll
    for (int i = 0; i < 4; ++i)
#pragma unroll
        for (int j = 0; j < 4; ++j)
#pragma unroll
            for (int r = 0; r < 4; ++r) E(m0 + i * 16 + 4 * (lane >> 4) + r, n0 + j * 16 + (lane & 15), acc[i][j][r]);
}

__device__ __forceinline__ bool row_prompt(int R, int& b, int& t) { if (R >= MP) return false; b = R / LP; t = (R % LP) - PADF; return t >= 0; }

struct EpiIn {
    float* ZQK; h16* GA; h16* U; h16* GS; float* out;
    __device__ __forceinline__ void operator()(int m, int n, float v) const {
        const int sec = n >> 9, j = n & 511;
        if (sec < 2) ZQK[(size_t)m * 1024 + n] = v;
        else if (sec == 2) {
            int b, t;
            if (m >= MP) out[O_VS + (size_t)(m - MP) * DATT + j] = v;
            else if (row_prompt(m, b, t)) out[O_VP + ((size_t)b * LSEQ + t) * DATT + j] = v;
        } else if (sec == 3) GA[(size_t)m * 512 + j] = (h16)v;
        else if (sec == 4) U[(size_t)m * 512 + j] = (h16)v;
        else GS[(size_t)m * 512 + j] = (h16)v;
    }
};
struct EpiGlu {
    const h16* Z; const h16* GS; const float* bglu; h16* MIX;
    __device__ __forceinline__ void operator()(int m, int n, float v) const {
        const float z = (float)Z[(size_t)m * 512 + n], gs = (float)GS[(size_t)m * 512 + n];
        MIX[(size_t)m * 1024 + 512 + n] = (h16)(z * sigmoidf_(v + bglu[n]) * siluf_(gs));
    }
};
struct EpiOut {
    const float* xp; const float* xs; float* out;
    __device__ __forceinline__ void operator()(int m, int n, float v) const {
        int b, t;
        if (m >= MP) { const size_t o = (size_t)(m - MP) * DM + n; out[O_YS + o] = xs[o] + v; }
        else if (row_prompt(m, b, t) && t >= NMETA) { const size_t o = ((size_t)b * SEQ + (t - NMETA)) * DM + n; out[O_YP + o] = xp[o] + v; }
    }
};

__global__ __launch_bounds__(256) void k_qknorm(float* __restrict__ ZQK, const float* __restrict__ gq, const float* __restrict__ gk, float* __restrict__ out) {
    const int tid = threadIdx.x, lane = tid & 63, wave = tid >> 6;
    const int R = blockIdx.x * 4 + wave; if (R >= MT) return;
    int b = 0, t = 0; const bool isS = R >= MP; if (!isS && !row_prompt(R, b, t)) return;
    float* row = ZQK + (size_t)R * 1024 + 16 * lane;
    float v[16]; float ss = 0.f;
#pragma unroll
    for (int e = 0; e < 16; ++e) { v[e] = row[e]; ss += v[e] * v[e]; }
    ss += __shfl_xor(ss, 1); ss += __shfl_xor(ss, 2);
    const float rstd = 1.0f / sqrtf(ss * (1.0f / 64.0f) + EPS);
    const bool isk = lane >= 32; const float* gg = isk ? gk : gq; const int d0 = (16 * lane) & 63;
#pragma unroll
    for (int e = 0; e < 16; ++e) v[e] = v[e] * rstd * gg[d0 + e];
    if (!isk) {
#pragma unroll
        for (int e = 0; e < 16; ++e) row[e] = v[e];
    } else {
        float* o = isS ? out + O_KS + (size_t)(R - MP) * DATT + (16 * lane - 512) : out + O_KP + ((size_t)b * LSEQ + t) * DATT + (16 * lane - 512);
#pragma unroll
        for (int e = 0; e < 16; ++e) o[e] = v[e];
    }
}

__device__ __forceinline__ float skip_thr(const float* gq, const float* gk) {
    float a = 0.f, b = 0.f;
    for (int d = 0; d < 64; ++d) { a = fmaxf(a, fabsf(gq[d])); b = fmaxf(b, fabsf(gk[d])); }
    return 104.0f + 2.0f * 8.0f * a * b + 1.0f;
}
__global__ __launch_bounds__(64) void k_attn_prompt(const float* __restrict__ ZQK, const float* __restrict__ outk, const float* __restrict__ outv,
                                                    const double* __restrict__ CUM, const h16* __restrict__ GA, h16* __restrict__ MIX,
                                                    const float* __restrict__ gq, const float* __restrict__ gk) {
    const int rb = blockIdx.x, h = blockIdx.y, b = blockIdx.z, lane = threadIdx.x;
    const int i0 = rb * 64; if (i0 + 63 < PADF) return;
    const int i = i0 + lane; const size_t R = (size_t)b * LP + i; const bool valid = i >= PADF;
    float q[64];
#pragma unroll
    for (int d = 0; d < 64; ++d) q[d] = valid ? ZQK[R * 1024 + h * 64 + d] : 0.f;
    const int ilo = i0 > PADF ? i0 : PADF;
    const float THR = skip_thr(gq, gk);
    const double c0 = CUM[((size_t)b * LP + ilo) * 8 + h];
    int lo = PADF, hi = ilo;
    while (lo < hi) { const int mid = (lo + hi) >> 1; if (c0 - CUM[((size_t)b * LP + mid) * 8 + h] >= -(double)THR) hi = mid; else lo = mid + 1; }
    const double cq = CUM[R * 8 + h];
    float m = -INFINITY, l = 0.f, o[64];
#pragma unroll
    for (int d = 0; d < 64; ++d) o[d] = 0.f;
    for (int s = lo; s <= i0 + 63; ++s) {
        const size_t kr = ((size_t)b * LSEQ + (s - PADF)) * DATT + h * 64;
        const float* kp = outk + kr; const float* vp = outv + kr;
        float dot = 0.f;
#pragma unroll
        for (int d = 0; d < 64; ++d) dot += q[d] * kp[d];
        const float logit = dot * 0.125f + (float)(cq - CUM[((size_t)b * LP + s) * 8 + h]);
        if (valid && s <= i) {
            const float mn = fmaxf(m, logit), sc = __expf(m - mn), p = __expf(logit - mn);
            l = l * sc + p; m = mn;
#pragma unroll
            for (int d = 0; d < 64; ++d) o[d] = o[d] * sc + p * vp[d];
        }
    }
    if (valid) {
        const float il = 1.0f / l;
#pragma unroll
        for (int d = 0; d < 64; ++d) { const float ga = (float)GA[R * 512 + h * 64 + d]; MIX[R * 1024 + h * 64 + d] = (h16)(o[d] * il * siluf_(ga)); }
    }
}
__global__ __launch_bounds__(64) void k_attn_sample(const float* __restrict__ ZQK, const float* __restrict__ ck, const float* __restrict__ cv,
                                                    const float* __restrict__ outk, const float* __restrict__ outv, const double* __restrict__ CUMS,
                                                    const h16* __restrict__ GA, h16* __restrict__ MIX) {
    const int sb = blockIdx.x, lane = threadIdx.x, h = blockIdx.y * 4 + (lane >> 4), st = lane & 15;
    const size_t R = (size_t)MP + sb * DS + st;
    float q[64];
#pragma unroll
    for (int d = 0; d < 64; ++d) q[d] = ZQK[R * 1024 + h * 64 + d];
    const double cq = CUMS[((size_t)sb * (PAST + DS) + PAST + st) * 8 + h];
    float m = -INFINITY, l = 0.f, o[64];
#pragma unroll
    for (int d = 0; d < 64; ++d) o[d] = 0.f;
    for (int s = 0; s < PAST + DS; ++s) {
        const float *kp, *vp;
        if (s < PAST) { const size_t r = (((size_t)sb * PAST + s) * NH + h) * HD; kp = ck + r; vp = cv + r; }
        else { const size_t r = (((size_t)sb * DS + (s - PAST)) * NH + h) * HD; kp = outk + r; vp = outv + r; }
        if (s <= PAST + st) {
            float dot = 0.f;
#pragma unroll
            for (int d = 0; d < 64; ++d) dot += q[d] * kp[d];
            const float logit = dot * 0.125f + (float)(cq - CUMS[((size_t)sb * (PAST + DS) + s) * 8 + h]);
            const float mn = fmaxf(m, logit), sc = __expf(m - mn), p = __expf(logit - mn);
            l = l * sc + p; m = mn;
#pragma unroll
            for (int d = 0; d < 64; ++d) o[d] = o[d] * sc + p * vp[d];
        }
    }
    const float il = 1.0f / l;
#pragma unroll
    for (int d = 0; d < 64; ++d) { const float ga = (float)GA[R * 512 + h * 64 + d]; MIX[R * 1024 + h * 64 + d] = (h16)(o[d] * il * siluf_(ga)); }
}

__global__ __launch_bounds__(64) void k_ssm_tables(const float* __restrict__ are, const float* __restrict__ aim, const float* __restrict__ ldt,
                                                   const float* __restrict__ bre, const float* __restrict__ bim, float2* __restrict__ ABAR, float2* __restrict__ BBAR) {
    const int g = blockIdx.x, p = threadIdx.x;
    const double dt = exp((double)ldt[g]), ar = (double)are[g * 64 + p], ai = (double)aim[g * 64 + p];
    const double mag = exp(ar * dt), abr = mag * cos(ai * dt), abi = mag * sin(ai * dt);
    ABAR[g * 64 + p] = make_float2((float)abr, (float)abi);
    { const double m64 = exp(64.0 * ar * dt); ABAR[NG * NST + g * 64 + p] = make_float2((float)(m64 * cos(64.0 * ai * dt)), (float)(m64 * sin(64.0 * ai * dt))); }
    { const double m16 = exp(16.0 * ar * dt); ABAR[2 * NG * NST + g * 64 + p] = make_float2((float)(m16 * cos(16.0 * ai * dt)), (float)(m16 * sin(16.0 * ai * dt))); }
    const double den = ar * ar + ai * ai, nr = abr - 1.0, ni = abi;
    const double cr = (nr * ar + ni * ai) / den, ci = (ni * ar - nr * ai) / den;
    for (int h = 0; h < 16; ++h) {
        const double br = (double)bre[(g * 64 + p) * 16 + h], bi = (double)bim[(g * 64 + p) * 16 + h];
        BBAR[(g * 64 + p) * 16 + h] = make_float2((float)(cr * br - ci * bi), (float)(cr * bi + ci * br));
    }
}
__global__ __launch_bounds__(64) void k_ssm_local(const h16* __restrict__ U, const float2* __restrict__ ABAR, const float2* __restrict__ BBAR, float2* __restrict__ SEND) {
    const int ch = blockIdx.x, g = blockIdx.y, p = threadIdx.x;
    const float2 a = ABAR[g * 64 + p];
    float2 bb[16];
#pragma unroll
    for (int h = 0; h < 16; ++h) bb[h] = BBAR[(g * 64 + p) * 16 + h];
    const size_t rowbase = (size_t)ch * 64;
    float xr = 0.f, xi = 0.f;
    for (int s = 0; s < 64; ++s) {
        const h16* up = U + (rowbase + s) * 512 + g * 16;
        float br = 0.f, bi = 0.f;
#pragma unroll
        for (int h = 0; h < 16; ++h) { const float u = (float)up[h]; br += bb[h].x * u; bi += bb[h].y * u; }
        const float nr = a.x * xr - a.y * xi + br, ni = a.x * xi + a.y * xr + bi; xr = nr; xi = ni;
    }
    SEND[((size_t)ch * NG + g) * NST + p] = make_float2(xr, xi);
}
__global__ __launch_bounds__(256) void k_ssm_carry(const float2* __restrict__ ABAR, const float2* __restrict__ SEND, float2* __restrict__ XST, float* __restrict__ out) {
    const int b = blockIdx.y, gp = blockIdx.x * 256 + threadIdx.x;
    const float2 a = ABAR[NG * NST + gp];
    float xr = 0.f, xi = 0.f;
    for (int c = 0; c < NCH; ++c) {
        const size_t idx = ((size_t)(b * NCH + c)) * (NG * NST) + gp;
        XST[idx] = make_float2(xr, xi);
        const float2 s = SEND[idx];
        const float nr = a.x * xr - a.y * xi + s.x, ni = a.x * xi + a.y * xr + s.y; xr = nr; xi = ni;
    }
    out[O_SRP + (size_t)b * NG * NST + gp] = xr; out[O_SIP + (size_t)b * NG * NST + gp] = xi;
}
template <int MODE>
__global__ __launch_bounds__(64) void k_ssm_out(const h16* __restrict__ U, const float2* __restrict__ ABAR, const float2* __restrict__ BBAR, const float2* __restrict__ XST,
                                                const float* __restrict__ sre, const float* __restrict__ sim, const float* __restrict__ cre, const float* __restrict__ cim,
                                                const float* __restrict__ dd, h16* __restrict__ Z, float* __restrict__ out) {
    __shared__ float xsr[64][65], xsi[64][65];
    const int ch = blockIdx.x, g = blockIdx.y, p = threadIdx.x;
    constexpr int NSTEP = MODE == 0 ? 64 : 16;
    const size_t rowbase = MODE == 0 ? (size_t)ch * 64 : (size_t)MP + (size_t)ch * DS;
    if (MODE == 0 && (ch % NCH) * 64 + 63 < PADF) return;
    const float2 a = ABAR[g * 64 + p];
    float2 bb[16];
#pragma unroll
    for (int h = 0; h < 16; ++h) bb[h] = BBAR[(g * 64 + p) * 16 + h];
    float xr, xi;
    if (MODE == 0) { const float2 x0 = XST[((size_t)ch * NG + g) * NST + p]; xr = x0.x; xi = x0.y; }
    else { xr = sre[((size_t)ch * NG + g) * NST + p]; xi = sim[((size_t)ch * NG + g) * NST + p]; }
    for (int s = 0; s < NSTEP; ++s) {
        const h16* up = U + (rowbase + s) * 512 + g * 16;
        float br = 0.f, bi = 0.f;
#pragma unroll
        for (int h = 0; h < 16; ++h) { const float u = (float)up[h]; br += bb[h].x * u; bi += bb[h].y * u; }
        const float nr = a.x * xr - a.y * xi + br, ni = a.x * xi + a.y * xr + bi; xr = nr; xi = ni;
        xsr[s][p] = xr; xsi[s][p] = xi;
    }
    if (MODE == 1) { out[O_SRS + ((size_t)ch * NG + g) * NST + p] = xr; out[O_SIS + ((size_t)ch * NG + g) * NST + p] = xi; }
    __syncthreads();
    const int s = p;
    if (s < NSTEP) {
        for (int hh = 0; hh < 16; ++hh) {
            const float* cr = cre + ((size_t)g * 16 + hh) * 64; const float* ci = cim + ((size_t)g * 16 + hh) * 64;
            float acc = 0.f;
#pragma unroll 8
            for (int pp = 0; pp < 64; ++pp) acc += cr[pp] * xsr[s][pp] - ci[pp] * xsi[s][pp];
            const float u = (float)U[(rowbase + s) * 512 + g * 16 + hh];
            const float y = acc + dd[g * 16 + hh] * u;
            Z[(rowbase + s) * 512 + g * 16 + hh] = (h16)gelu_tanh(y);
        }
    }
}

extern "C" void kernel_launch(void* const* d_in, const int* in_sizes, int n_in, void* d_out, int out_size, void* d_ws, size_t ws_size, hipStream_t stream) {
    if (n_in != 24 || (size_t)out_size != O_END || ws_size < WS_END) { fprintf(stderr, "kernel_launch: unexpected sizes n_in %d out %d ws %zu (need %zu)\n", n_in, out_size, ws_size, (size_t)WS_END); return; }
    const float* xp = (const float*)d_in[0]; const float* xs = (const float*)d_in[1];
    const float* ck = (const float*)d_in[2]; const float* cv = (const float*)d_in[3]; const float* clf = (const float*)d_in[4];
    const float* sre = (const float*)d_in[5]; const float* sim = (const float*)d_in[6]; const float* meta = (const float*)d_in[7];
    const float* ng = (const float*)d_in[8]; const float* win = (const float*)d_in[9]; const float* bf = (const float*)d_in[10];
    const float* gq = (const float*)d_in[11]; const float* gk = (const float*)d_in[12];
    const float* are = (const float*)d_in[13]; const float* aim = (const float*)d_in[14]; const float* ldt = (const float*)d_in[15];
    const float* bre = (const float*)d_in[16]; const float* bim = (const float*)d_in[17]; const float* cre = (const float*)d_in[18]; const float* cim = (const float*)d_in[19];
    const float* dd = (const float*)d_in[20]; const float* wglu = (const float*)d_in[21]; const float* bglu = (const float*)d_in[22]; const float* wout = (const float*)d_in[23];
    float* out = (float*)d_out; char* ws = (char*)d_ws;
    h16* WINT = (h16*)(ws + WS_WINT); h16* WGLUT = (h16*)(ws + WS_WGLUT); h16* WOUTT = (h16*)(ws + WS_WOUTT); h16* XN = (h16*)(ws + WS_XN);
    float* LOGF = (float*)(ws + WS_LOGF); double* CUM = (double*)(ws + WS_CUM); double* CUMS = (double*)(ws + WS_CUMS); float* ZQK = (float*)(ws + WS_ZQK);
    h16* GA = (h16*)(ws + WS_GA); h16* U = (h16*)(ws + WS_U); h16* GS = (h16*)(ws + WS_GS); h16* Z = (h16*)(ws + WS_Z); h16* MIX = (h16*)(ws + WS_MIX);
    float2* ABAR = (float2*)(ws + WS_ABAR); float2* BBAR = (float2*)(ws + WS_BBAR); float2* SEND = (float2*)(ws + WS_SEND); float2* XST = (float2*)(ws + WS_XST);

    k_transpose<1><<<dim3(3072 / 64, 1024 / 64), 256, 0, stream>>>(win, 1024, DIN, WINT);
    k_transpose<0><<<dim3(512 / 64, 512 / 64), 256, 0, stream>>>(wglu, 512, 512, WGLUT);
    k_transpose<0><<<dim3(1024 / 64, 1024 / 64), 256, 0, stream>>>(wout, 1024, 1024, WOUTT);
    k_ssm_tables<<<NG, 64, 0, stream>>>(are, aim, ldt, bre, bim, ABAR, BBAR);
    k_rownorm<<<2048, 256, 0, stream>>>(xp, xs, meta, ng, win, bf, XN, LOGF, out);
    k_cum_prompt<<<dim3(NH, NB), 256, 0, stream>>>(LOGF, CUM);
    k_cum_sample<<<dim3(NH, DB), 64, 0, stream>>>(LOGF, clf, CUMS);
    k_gemm<EpiIn><<<dim3(3072 / 128, MT / 128), 256, 0, stream>>>(XN, WINT, 1024, EpiIn{ZQK, GA, U, GS, out});
    k_qknorm<<<MT / 4, 256, 0, stream>>>(ZQK, gq, gk, out);
    k_attn_prompt<<<dim3(NCH, NH, NB), 64, 0, stream>>>(ZQK, out + O_KP, out + O_VP, CUM, GA, MIX, gq, gk);
    k_attn_sample<<<dim3(DB, 2), 64, 0, stream>>>(ZQK, ck, cv, out + O_KS, out + O_VS, CUMS, GA, MIX);
    k_ssm_local<<<dim3(NB * NCH, NG), 64, 0, stream>>>(U, ABAR, BBAR, SEND);
    k_ssm_carry<<<dim3(NG * NST / 256, NB), 256, 0, stream>>>(ABAR, SEND, XST, out);
    k_ssm_out<0><<<dim3(NB * NCH, NG), 64, 0, stream>>>(U, ABAR, BBAR, XST, sre, sim, cre, cim, dd, Z, out);
    k_ssm_out<1><<<dim3(DB, NG), 64, 0, stream>>>(U, ABAR, BBAR, XST, sre, sim, cre, cim, dd, Z, out);
    k_gemm<EpiGlu><<<dim3(512 / 128, MT / 128), 256, 0, stream>>>(Z, WGLUT, 512, EpiGlu{Z, GS, bglu, MIX});
    k_gemm<EpiOut><<<dim3(1024 / 128, MT / 128), 256, 0, stream>>>(MIX, WOUTT, 1024, EpiOut{xp, xs, out});
}
```

```cpp
#include <hip/hip_runtime.h>
#include <stdint.h>
#include <cstdio>

typedef _Float16 h16;
typedef _Float16 h16x8 __attribute__((ext_vector_type(8)));
typedef _Float16 h16x4 __attribute__((ext_vector_type(4)));
typedef float f32x4 __attribute__((ext_vector_type(4)));
#define LAS __attribute__((address_space(3)))

constexpr int DM = 1024, NB = 2, SEQ = 16384, NMETA = 16, LSEQ = SEQ + NMETA, DB = 32, DS = 16, PAST = 1024;
constexpr int NH = 8, HD = 64, DATT = 512, DSSM = 512, NG = 32, SG = 16, NST = 64, DIN = 3080;
constexpr int PADF = 240, LP = 16640;
constexpr int MP = NB * LP;
constexpr int MS = DB * DS;
constexpr int MT = MP + MS;
constexpr int NCH = LP / 64;
constexpr float EPS = 1e-6f;
constexpr int NWAVES = 8, NTHREADS = 512;

constexpr size_t O_YP = 0;
constexpr size_t O_YS = O_YP + (size_t)NB * SEQ * DM;
constexpr size_t O_KP = O_YS + (size_t)DB * DS * DM;
constexpr size_t O_VP = O_KP + (size_t)NB * LSEQ * DATT;
constexpr size_t O_FP = O_VP + (size_t)NB * LSEQ * DATT;
constexpr size_t O_SRP = O_FP + (size_t)NB * LSEQ * NH;
constexpr size_t O_SIP = O_SRP + (size_t)NB * NG * NST;
constexpr size_t O_KS = O_SIP + (size_t)NB * NG * NST;
constexpr size_t O_VS = O_KS + (size_t)DB * DS * DATT;
constexpr size_t O_FS = O_VS + (size_t)DB * DS * DATT;
constexpr size_t O_SRS = O_FS + (size_t)DB * DS * NH;
constexpr size_t O_SIS = O_SRS + (size_t)DB * NG * NST;
constexpr size_t O_END = O_SIS + (size_t)DB * NG * NST;

constexpr size_t al256(size_t x) { return (x + 255) & ~(size_t)255; }
constexpr size_t WS_CTL = 0, CTL_ZERO_BYTES = 65536;
constexpr size_t WS_WINT = CTL_ZERO_BYTES;
constexpr size_t WS_WGLUT = al256(WS_WINT + (size_t)3072 * 1024 * 2);
constexpr size_t WS_WOUTT = al256(WS_WGLUT + (size_t)512 * 512 * 2);
constexpr size_t WS_XN = al256(WS_WOUTT + (size_t)1024 * 1024 * 2);
constexpr size_t WS_LOGF = al256(WS_XN + (size_t)MT * 1024 * 2);
constexpr size_t WS_CUM = al256(WS_LOGF + (size_t)MT * 8 * 4);
constexpr size_t WS_CUMS = al256(WS_CUM + (size_t)MT * 8 * 8);
constexpr size_t WS_Q = al256(WS_CUMS + (size_t)DB * 1040 * 8 * 8);
constexpr size_t WS_K = al256(WS_Q + (size_t)MT * 512 * 2);
constexpr size_t WS_V = al256(WS_K + (size_t)MT * 512 * 2);
constexpr size_t WS_GA = al256(WS_V + (size_t)MT * 512 * 2);
constexpr size_t WS_U = al256(WS_GA + (size_t)MT * 512 * 2);
constexpr size_t WS_GS = al256(WS_U + (size_t)MT * 512 * 2);
constexpr size_t WS_Z = al256(WS_GS + (size_t)MT * 512 * 2);
constexpr size_t WS_MIX = al256(WS_Z + (size_t)MT * 512 * 2);
constexpr size_t WS_ABAR = al256(WS_MIX + (size_t)MT * 1024 * 2);
constexpr size_t WS_BBAR = al256(WS_ABAR + (size_t)3 * NG * NST * 8);
constexpr size_t WS_SEND = al256(WS_BBAR + (size_t)NG * NST * SG * 8);
constexpr size_t WS_XST = al256(WS_SEND + (size_t)NB * NCH * NG * NST * 8);
static_assert(WS_K - WS_Q == (size_t)MT * 1024 && WS_V - WS_K == (size_t)MT * 1024 && WS_GA - WS_V == (size_t)MT * 1024 && WS_U - WS_GA == (size_t)MT * 1024 && WS_GS - WS_U == (size_t)MT * 1024, "Q|K|V|GA|U|GS consecutive");
constexpr size_t WS_ANCH = al256(WS_XST + (size_t)NB * NCH * NG * NST * 8);
constexpr size_t WS_KBT = al256(WS_ANCH + (size_t)16 * 264 * 8);
constexpr size_t WS_NEG1 = al256(WS_KBT + (size_t)16 * 260 * 1024);
constexpr size_t WS_POW = al256(WS_NEG1 + 1024);
constexpr size_t WS_WSC = al256(WS_POW + (size_t)NG * 65 * NST * 8);
constexpr size_t WS_T1 = al256(WS_WSC + 256);
constexpr size_t WS_T2 = al256(WS_T1 + (size_t)NG * 32 * 8 * 64 * 16);
constexpr size_t WS_CMF = al256(WS_T2 + (size_t)NG * 32 * 64 * 16);
constexpr size_t WS_END = al256(WS_CMF + (size_t)NG * 4 * 64 * 16);
constexpr int CW_Q = 8192;
constexpr int CW_BAR = 1024;

constexpr int RING_BYTES = 143360;
constexpr int LDSCTL_OFF = RING_BYTES, MISC_OFF = LDSCTL_OFF + 320;
constexpr int LDS_BYTES = 147456;

__device__ __forceinline__ float wave_sum(float v) {
#pragma unroll
    for (int o = 32; o > 0; o >>= 1) v += __shfl_xor(v, o);
    return v;
}
__device__ __forceinline__ float sigmoidf_(float x) { return 1.0f / (1.0f + __expf(-x)); }
__device__ __forceinline__ float siluf_(float x) { return x * sigmoidf_(x); }
__device__ __forceinline__ float gelu_tanh(float y) { return 0.5f * y * (1.0f + tanhf(0.7978845608028654f * (y + 0.044715f * y * y * y))); }
#define LDS_WAIT() asm volatile("s_waitcnt lgkmcnt(0)" ::: "memory")

#define XB_TMO      128
#define XB_XCNT(j)  (256  + 64 * (j))
#define XB_XSUB(j)  (1280 + 64 * (j))
#define XB_XGEN(j)  (2304 + 64 * (j))
#define XB_TOP      3328
#define XB_TOPGEN   3392
#define XCD_BAR_WORDS 3456
#define XB_SPIN_CAP (1u << 20)
__device__ __forceinline__ unsigned xb_ld(unsigned* p)              { return __hip_atomic_load(p, __ATOMIC_RELAXED, __HIP_MEMORY_SCOPE_AGENT); }
__device__ __forceinline__ unsigned xb_add(unsigned* p, unsigned v) { return __hip_atomic_fetch_add(p, v, __ATOMIC_RELAXED, __HIP_MEMORY_SCOPE_AGENT); }
__device__ __forceinline__ unsigned xb_xcc_id() { return (unsigned)__builtin_amdgcn_s_getreg((3 << 11) | 20) & 0xFu; }
#define XB_SPIN(cond, bar) do { unsigned _sp = 0; while (cond) { __builtin_amdgcn_s_sleep(1); \
    if ((++_sp & 255u) == 0u) { if (xb_ld(&(bar)[XB_TMO])) break; if (_sp > XB_SPIN_CAP) { atomicAdd(&(bar)[XB_TMO], 1u); break; } } } } while (0)
struct XcdBarrier { unsigned* bar; unsigned x; volatile LAS unsigned* st; };
__device__ __forceinline__ XcdBarrier xcd_barrier_post(unsigned* bar, volatile LAS unsigned* st) {
    XcdBarrier b; b.bar = bar; b.x = xb_xcc_id(); b.st = st;
    if (threadIdx.x == 0) (void)xb_add(&bar[XB_XCNT(b.x)], 1u);
    return b;
}
__device__ __forceinline__ void xcd_barrier_complete(unsigned* bar, unsigned x, unsigned& nloc, unsigned& nx) {
    const unsigned G = gridDim.x * gridDim.y * gridDim.z;
    unsigned sum, cnt, mine, sp = 0u;
    for (;;) {
        sum = 0u; cnt = 0u; mine = 0u;
#pragma unroll
        for (unsigned j = 0; j < 16; ++j) { const unsigned c = xb_ld(&bar[XB_XCNT(j)]); sum += c; cnt += (c > 0u) ? 1u : 0u; mine = (j == x) ? c : mine; }
        if (sum == G) break;
        __builtin_amdgcn_s_sleep(1);
        if ((++sp & 255u) == 0u) { if (xb_ld(&bar[XB_TMO])) break; if (sp > XB_SPIN_CAP) { atomicAdd(&bar[XB_TMO], 1u); break; } }
    }
    nloc = mine > 0u ? mine : 1u; nx = cnt > 0u ? cnt : 1u;
}
__device__ __forceinline__ void xcd_barrier(const XcdBarrier& b) {
    asm volatile("s_waitcnt vmcnt(0)" ::: "memory");
    __syncthreads();
    if (threadIdx.x == 0) {
        unsigned* bar = b.bar;
        __builtin_amdgcn_s_waitcnt(0);
        unsigned nloc = b.st[0], nx = b.st[1];
        if (nloc == 0u) { xcd_barrier_complete(bar, b.x, nloc, nx); b.st[0] = nloc; b.st[1] = nx; }
        const unsigned old = xb_add(&bar[XB_XSUB(b.x)], 1u);
        const unsigned gen = old / nloc;
        if (old + 1u == (gen + 1u) * nloc) {
            __builtin_amdgcn_fence(__ATOMIC_RELEASE, "agent");
            asm volatile("s_waitcnt vmcnt(0)" ::: "memory");
            const unsigned og = xb_add(&bar[XB_TOP], 1u);
            const unsigned tg = og / nx;
            if (og + 1u == (tg + 1u) * nx) xb_add(&bar[XB_TOPGEN], 1u);
            else XB_SPIN(xb_ld(&bar[XB_TOPGEN]) == tg, bar);
            __builtin_amdgcn_fence(__ATOMIC_ACQUIRE, "agent");
            xb_add(&bar[XB_XGEN(b.x)], 1u);
            asm volatile("s_waitcnt vmcnt(0)" ::: "memory");
        } else {
            XB_SPIN(xb_ld(&bar[XB_XGEN(b.x)]) == gen, bar);
            __builtin_amdgcn_fence(__ATOMIC_ACQUIRE, "agent");
            asm volatile("s_waitcnt vmcnt(0)" ::: "memory");
        }
    }
    __syncthreads();
}

struct Args { const float* in[24]; float* out; unsigned char* ws; };
struct Ctx {
    int tid, lane, wave, vcu, G, gw, NGW;
    const float *xp, *xs, *ck, *cv, *clf, *sre, *sim, *meta, *ng, *win, *bf, *gq, *gk, *are, *aim, *ldt, *bre, *bim, *cre, *cim, *dd, *wglu, *bglu, *wout;
    float* out;
    h16 *WINT, *WGLUT, *WOUTT, *XN, *GA, *U, *GS, *Z, *MIX;
    h16 *Q16, *K16, *V16;
    float *LOGF; double *CUM, *CUMS, *ANCH; float2 *ABAR, *BBAR, *SEND, *XST, *POW; float* WSC; h16 *T1, *T2, *CMF; char *KBT, *NEG1; unsigned* ctl;
};

__device__ __forceinline__ bool row_prompt(int R, int& b, int& t) { if (R >= MP) return false; b = R / LP; t = (R % LP) - PADF; return t >= 0; }

__device__ __forceinline__ void p0_transpose_item(const float* W, int K, int ldw, h16* WT, int k0, int n0, int c0, float* scr, int lane) {
#pragma unroll 8
    for (int i = 0; i < 32; ++i) { const int kk = 2 * i + (lane >> 5); scr[kk * 33 + (lane & 31)] = W[(size_t)(k0 + kk) * ldw + c0 + (lane & 31)]; }
    LDS_WAIT();
    const int c = lane & 7;
#pragma unroll
    for (int j = 0; j < 4; ++j) { const int n = (lane >> 3) + 8 * j; const float* s = scr + (8 * c) * 33 + n;
        h16x8 o = {(h16)s[0 * 33], (h16)s[1 * 33], (h16)s[2 * 33], (h16)s[3 * 33], (h16)s[4 * 33], (h16)s[5 * 33], (h16)s[6 * 33], (h16)s[7 * 33]};
        *(h16x8*)(WT + (size_t)(n0 + n) * K + k0 + 8 * c) = o; }
    LDS_WAIT();
}
__device__ __forceinline__ void p0_tables(const Ctx& C, int idx) {
    const int g = idx >> 6, p = idx & 63;
    const double dt = exp((double)C.ldt[g]), ar = (double)C.are[idx], ai = (double)C.aim[idx];
    const double mag = exp(ar * dt), abr = mag * cos(ai * dt), abi = mag * sin(ai * dt);
    C.ABAR[idx] = make_float2((float)abr, (float)abi);
    { const double m64 = exp(64.0 * ar * dt); C.ABAR[NG * NST + idx] = make_float2((float)(m64 * cos(64.0 * ai * dt)), (float)(m64 * sin(64.0 * ai * dt))); }
    { const double m16 = exp(16.0 * ar * dt); C.ABAR[2 * NG * NST + idx] = make_float2((float)(m16 * cos(16.0 * ai * dt)), (float)(m16 * sin(16.0 * ai * dt))); }
    if (p == 0) C.WSC[g] = (float)exp2(floor(log2(dt)));
    const double den = ar * ar + ai * ai, nr = abr - 1.0, ni = abi;
    const double cr = (nr * ar + ni * ai) / den, ci = (ni * ar - nr * ai) / den;
    for (int h = 0; h < 16; ++h) {
        const double br = (double)C.bre[idx * 16 + h], bi = (double)C.bim[idx * 16 + h];
        C.BBAR[idx * 16 + h] = make_float2((float)(cr * br - ci * bi), (float)(cr * bi + ci * br));
    }
}
__device__ __forceinline__ void p0_row(const Ctx& C, int R, const float* wf) {
    const int lane = C.lane;
    const float* src = nullptr; float* olf = nullptr;
    if (R < MP) { const int b = R / LP, i = R % LP, t = i - PADF;
        if (t >= 0) { src = (t < NMETA) ? C.meta + (size_t)t * DM : C.xp + ((size_t)b * SEQ + (t - NMETA)) * DM; olf = C.out + O_FP + ((size_t)b * LSEQ + t) * NH; } }
    else { const int r = R - MP; src = C.xs + (size_t)r * DM; olf = C.out + O_FS + (size_t)r * NH; }
    uint2* xo = (uint2*)(C.XN + (size_t)R * DM);
    if (!src) {
#pragma unroll
        for (int j = 0; j < 4; ++j) xo[lane + 64 * j] = make_uint2(0u, 0u);
        if (lane < 8) C.LOGF[(size_t)R * 8 + lane] = 0.f;
        return;
    }
    float4 v[4]; float ss = 0.f;
#pragma unroll
    for (int j = 0; j < 4; ++j) { v[j] = ((const float4*)src)[lane + 64 * j]; ss += v[j].x * v[j].x + v[j].y * v[j].y + v[j].z * v[j].z + v[j].w * v[j].w; }
    ss = wave_sum(ss);
    const float rstd = 1.0f / sqrtf(ss * (1.0f / DM) + EPS);
    float fl[8];
#pragma unroll
    for (int h = 0; h < 8; ++h) fl[h] = 0.f;
#pragma unroll
    for (int j = 0; j < 4; ++j) {
        const float4 gv = ((const float4*)C.ng)[lane + 64 * j];
        v[j].x *= rstd * gv.x; v[j].y *= rstd * gv.y; v[j].z *= rstd * gv.z; v[j].w *= rstd * gv.w;
        h16x4 o = {(h16)v[j].x, (h16)v[j].y, (h16)v[j].z, (h16)v[j].w};
        xo[lane + 64 * j] = __builtin_bit_cast(uint2, o);
#pragma unroll
        for (int h = 0; h < 8; ++h) { const float4 w = *(const float4*)&wf[h * 1024 + 4 * (lane + 64 * j)]; fl[h] += v[j].x * w.x + v[j].y * w.y + v[j].z * w.z + v[j].w * w.w; }
    }
    float mine = 0.f;
#pragma unroll
    for (int h = 0; h < 8; ++h) { const float s = wave_sum(fl[h]); if (lane == h) mine = s; }
    if (lane < 8) {
        const float x = mine + C.bf[lane];
        const float lf = fminf(x, 0.f) - log1pf(expf(-fabsf(x)));
        C.LOGF[(size_t)R * 8 + lane] = lf; olf[lane] = lf;
    }
}
__device__ __forceinline__ void phase0(const Ctx& C, unsigned char* lds) {
    float* wf = (float*)lds;
    float* scr = (float*)(lds + 32768 + C.wave * 8448);
    for (int i = C.tid; i < 8192; i += NTHREADS) { const int k = i >> 3, h = i & 7; wf[h * 1024 + k] = C.win[(size_t)k * DIN + 1536 + h]; }
    __syncthreads();
    constexpr int I_IN = 16 * 96, I_GLU = 8 * 16, I_OUT = 16 * 32;
    for (int it = C.gw; it < I_IN + I_GLU + I_OUT; it += C.NGW) {
        int r = it;
        if (r < I_IN) { const int kb = r / 96, nb = r % 96, n0 = 32 * nb;
            const int T = n0 >> 8, bj = (n0 >> 7) & 1, wc = (n0 >> 5) & 3, sec = T >> 1;
            const int c0 = (sec < 3 ? 512 * sec : 512 * sec + 8) + 256 * (T & 1) + 64 * wc + 32 * bj;
            p0_transpose_item(C.win, 1024, DIN, C.WINT, 64 * kb, n0, c0, scr, C.lane); continue; } r -= I_IN;
        if (r < I_GLU) { const int kb = r / 16, nb = r % 16; p0_transpose_item(C.wglu, 512, 512, C.WGLUT, 64 * kb, 32 * nb, 32 * nb, scr, C.lane); continue; } r -= I_GLU;
        { const int kb = r / 32, nb = r % 32; p0_transpose_item(C.wout, 1024, 1024, C.WOUTT, 64 * kb, 32 * nb, 32 * nb, scr, C.lane); }
    }
    for (int it = C.vcu * NTHREADS + C.tid; it < NG * 65 * NST; it += C.G * NTHREADS) {
        const int p = it & 63, n = (it >> 6) % 65, g = it / (65 * 64);
        const double dt = exp((double)C.ldt[g]), e = (double)n * dt, m = exp(e * (double)C.are[g * 64 + p]), th = e * (double)C.aim[g * 64 + p];
        C.POW[it] = make_float2((float)(m * cos(th)), (float)(m * sin(th)));
    }
    { const int gt = C.vcu * NTHREADS + C.tid; if (gt < NG * NST) p0_tables(C, gt); if (gt < 16) *(uint4*)(C.NEG1 + gt * 16) = make_uint4(0xBC00BC00u, 0x0000BC00u, 0u, 0u); }
    for (int R = C.gw; R < MT; R += C.NGW) p0_row(C, R, wf);
}

__device__ __forceinline__ void split3(float x, unsigned& w0, unsigned& w1) {
    const h16 a = (h16)x; const float r1 = x - (float)a; const h16 b = (h16)r1; const float r2 = r1 - (float)b; const h16 c = (h16)r2;
    w0 = (unsigned)__builtin_bit_cast(unsigned short, a) | ((unsigned)__builtin_bit_cast(unsigned short, b) << 16); w1 = (unsigned)__builtin_bit_cast(unsigned short, c);
}
__device__ __forceinline__ void cum_prompt_wg(const Ctx& C, unsigned char* lds, int b, int h) {
    double* part = (double*)lds;
    const size_t base = (size_t)b * LP; const int bh = b * 8 + h;
    for (int vt = C.tid; vt < 520; vt += NTHREADS) { double s = 0.0; for (int i = 0; i < 32; ++i) s += (double)C.LOGF[(base + 32 * vt + i) * 8 + h]; part[vt] = s; }
    __syncthreads();
    if (C.tid == 0) { double r = 0.0; for (int i = 0; i < 520; ++i) { const double t = part[i]; part[i] = r; r += t; } part[520] = r; }
    __syncthreads();
    const unsigned short negbig = __builtin_bit_cast(unsigned short, (h16)-60000.0f);
    for (int vt = C.tid; vt < 520; vt += NTHREADS) {
        double r = part[vt]; const int tau = vt >> 1; const double A = part[2 * tau];
        if ((vt & 1) == 0) C.ANCH[bh * 264 + tau] = A;
        for (int i = 0; i < 32; ++i) {
            const int row = 32 * vt + i; r += (double)C.LOGF[(base + row) * 8 + h]; C.CUM[(base + row) * 8 + h] = r;
            unsigned w0, w1; split3((float)((A - r) * 1.4426950408889634), w0, w1);
            if (row < PADF) { w0 = negbig; w1 = 0u; }
            *(uint4*)(C.KBT + (((size_t)bh * 260 + tau) * 64 + (row & 63)) * 16) = make_uint4(w0, w1 | 0x3C000000u, 0x3C003C00u, 0u);
        }
    }
    if (C.tid == 0) C.ANCH[bh * 264 + 260] = part[520];
    __syncthreads();
}
__device__ __forceinline__ void cum_sample_wave(const Ctx& C, int item) {
    const int sb = item >> 3, h = item & 7;
    if (C.lane != 0) return;
    double r = 0.0;
    for (int s = 0; s < PAST + DS; ++s) {
        const float v = (s < PAST) ? C.clf[((size_t)sb * PAST + s) * NH + h] : C.LOGF[((size_t)MP + sb * DS + (s - PAST)) * 8 + h];
        r += (double)v; C.CUMS[((size_t)sb * (PAST + DS) + s) * 8 + h] = r;
    }
}

constexpr float C2 = 0.125f * 1.4426950408889634f;
namespace pg8 {
#define PG8_LAS __attribute__((address_space(3)))
constexpr int BM = 256, BK = 64, HALF = 128, HTB = HALF * BK * 2  , STAGE_BYTES = 8 * HTB, NXCD = 8, WGM = 8;

__host__ __device__ __forceinline__ int lds_byte(int r, int c) { const int st = (r >> 4) * 2 + (c >> 5), rr = r & 15, cc = c & 31, ob = rr * 64 + cc * 2; return st * 1024 + (ob ^ (((ob >> 9) & 1) << 5)); }
__host__ __device__ __forceinline__ void stage_rc(int b, int& R, int& C) { const int st = b / 1024, sb = b % 1024, swz = sb ^ (((sb >> 9) & 1) << 5); R = (st >> 1) * 16 + swz / 64; C = (st & 1) * 32 + (swz % 64) / 2; }
__host__ __device__ __forceinline__ int perm32(int rho) { const int n = rho >> 4, i = rho & 15; return 8 * (i >> 2) + 4 * n + (i & 3); }
struct Unit { int pm, pn; };
struct Gemm { const h16* A; const h16* Bt; int M, N, K; };

struct StaticOrder {
    int nM, nN, nwg, G, c;
    __host__ __device__ void init(int M, int N, int G_, int c_) { nM = M / BM; nN = N / BM; nwg = nM * nN; G = G_; c = c_; }
    __host__ __device__ bool next(int i, Unit& u) const {
        const long L = (long)i * G + c; if (L >= nwg) return false;
        int wgid = (int)L; { const int q = nwg / NXCD, r = nwg % NXCD, xcd = wgid % NXCD, off = wgid / NXCD; wgid = (xcd < r ? xcd * (q + 1) : r * (q + 1) + (xcd - r) * q) + off; }
        const int nig = WGM * nN, gid = wgid / nig, fm = gid * WGM, gsz = (nM - fm) < WGM ? (nM - fm) : WGM;
        u.pm = fm + ((wgid % nig) % gsz); u.pn = (wgid % nig) / gsz; return true;
    }
    __device__ __forceinline__ void a_ready(const Unit&) const {}
    __device__ __forceinline__ void done(const Unit&) const {}
};

template <class Epi, class Sched, bool ALIGN_EPI = false, bool SP2 = false>
__device__ __forceinline__ void gemm_phase(PG8_LAS unsigned char* lds, const Gemm g, const Sched& S, const Epi& E) {
    int tid_ = threadIdx.x; asm volatile("" : "+v"(tid_));
    const int tid = tid_, wid = __builtin_amdgcn_readfirstlane(tid >> 6), lane = tid & 63, wr = wid >> 2, wc = wid & 3, fr = lane & 15, fq = lane >> 4;
    const int K = g.K, nt = K / BK;
    unsigned voffA[2], voffB[2];
#pragma unroll
    for (int i = 0; i < 2; ++i) { int R, C; stage_rc(tid * 16 + i * 8192, R, C); const int Rb = Epi::PERM ? ((R & ~31) + perm32(R & 31)) : R;
        voffA[i] = (unsigned)(R * K + C) * 2u; voffB[i] = (unsigned)(Rb * K + C) * 2u; }
    const size_t kstep = (size_t)(BK * 2);
    const size_t hstep = (size_t)HALF * K * 2;
    const size_t tstep = 2 * hstep;
    const unsigned ldsw = (unsigned)wid * 1024u;
    const int aoff = lds_byte(wr * 64 + fr, fq * 8), boff = lds_byte(wc * 32 + fr, fq * 8);
#define PG8_SA(b, h) (((b) * 2 + (h)) * HTB)
#define PG8_SB(b, h) ((4 + (b) * 2 + (h)) * HTB)
#define PG8_STAGE(bufoff, gbase, voff) do { _Pragma("unroll") for (int _i = 0; _i < 2; ++_i) \
        __builtin_amdgcn_global_load_lds((const unsigned*)((const char*)(gbase) + (voff)[_i]), (PG8_LAS unsigned*)(lds + (bufoff) + ldsw + _i * 8192), 16, 0, 0); } while (0)
#define PG8_LDA(dst, b, h) do { _Pragma("unroll") for (int m = 0; m < 4; ++m) _Pragma("unroll") for (int k = 0; k < 2; ++k) dst[m][k] = *(const PG8_LAS h16x8*)(lds + PG8_SA(b, h) + aoff + m * 2048 + k * 1024); } while (0)
#define PG8_LDB(dst, b, h) do { _Pragma("unroll") for (int n = 0; n < 2; ++n) _Pragma("unroll") for (int k = 0; k < 2; ++k) dst[n][k] = *(const PG8_LAS h16x8*)(lds + PG8_SB(b, h) + boff + n * 2048 + k * 1024); } while (0)
#define PG8_MMA(ai, bj, At, Bt) do { __builtin_amdgcn_s_setprio(1); _Pragma("unroll") for (int m = 0; m < 4; ++m) _Pragma("unroll") for (int n = 0; n < 2; ++n) _Pragma("unroll") for (int k = 0; k < 2; ++k) \
        acc[ai][bj][m][n] = __builtin_amdgcn_mfma_f32_16x16x32_f16(Bt[n][k], At[m][k], acc[ai][bj][m][n], 0, 0, 0); __builtin_amdgcn_s_setprio(0); } while (0)
#define PG8_WAIT_V(n) asm volatile("s_waitcnt vmcnt(" #n ")" ::: "memory")
#define PG8_WAIT_L(n) asm volatile("s_waitcnt lgkmcnt(" #n ")" ::: "memory")
#define PG8_BAR __builtin_amdgcn_s_barrier()
#define PG8_SCHED __builtin_amdgcn_sched_barrier(0)
    Unit cur, nxt; int ui = 0;
    if (!S.next(0, cur)) return;
    f32x4 acc[2][2][4][2];
#pragma unroll
    for (int a = 0; a < 2; ++a)
#pragma unroll
        for (int b = 0; b < 2; ++b)
#pragma unroll
            for (int m = 0; m < 4; ++m)
#pragma unroll
                for (int n = 0; n < 2; ++n) acc[a][b][m][n] = (f32x4){0.f, 0.f, 0.f, 0.f};
    h16x8 At[4][2], B0[2][2], B1[2][2];
    const char* cA = (const char*)g.A + (size_t)cur.pm * tstep; const char* cB = (const char*)g.Bt + (size_t)cur.pn * tstep;
    S.a_ready(cur);
    if constexpr (SP2) {
        PG8_STAGE(PG8_SB(0, 0), cB, voffB); PG8_STAGE(PG8_SB(0, 1), cB + hstep, voffB); PG8_STAGE(PG8_SA(0, 0), cA, voffA); PG8_STAGE(PG8_SA(0, 1), cA + hstep, voffA);
        if (wr == 1) PG8_BAR;
        PG8_WAIT_V(2); PG8_BAR;
        PG8_STAGE(PG8_SB(1, 0), cB + kstep, voffB); PG8_STAGE(PG8_SA(1, 0), cA + kstep, voffA); PG8_STAGE(PG8_SB(1, 1), cB + hstep + kstep, voffB);
        PG8_WAIT_V(6); PG8_BAR;
    } else {
        PG8_STAGE(PG8_SB(0, 0), cB, voffB); PG8_STAGE(PG8_SA(0, 0), cA, voffA); PG8_STAGE(PG8_SB(0, 1), cB + hstep, voffB); PG8_STAGE(PG8_SA(0, 1), cA + hstep, voffA);
        if (wr == 1) PG8_BAR;
        PG8_WAIT_V(4); PG8_BAR;
        PG8_STAGE(PG8_SB(1, 0), cB + kstep, voffB); PG8_STAGE(PG8_SA(1, 0), cA + kstep, voffA); PG8_STAGE(PG8_SB(1, 1), cB + hstep + kstep, voffB);
        PG8_WAIT_V(6); PG8_BAR;
    }
    for (;;) {
        const bool has_next = S.next(ui + 1, nxt);
        const char* nA = has_next ? (const char*)g.A + (size_t)nxt.pm * tstep : cA; const char* nB = has_next ? (const char*)g.Bt + (size_t)nxt.pn * tstep : cB;
        for (int t = 0; t < nt; t += 2) {
            const bool last = (t == nt - 2);
            const char* a1 = cA + (size_t)(t + 1) * kstep;
            const char* a2 = last ? nA : cA + (size_t)(t + 2) * kstep; const char* b2 = last ? nB : cB + (size_t)(t + 2) * kstep;
            const char* a3 = a2 + kstep; const char* b3 = b2 + kstep;
            if (last && has_next) S.a_ready(nxt);
            if constexpr (SP2) {
            PG8_LDB(B0, 0, 0); PG8_LDB(B1, 0, 1); PG8_SCHED; PG8_LDA(At, 0, 0); PG8_STAGE(PG8_SA(1, 1), a1 + hstep, voffA);
            PG8_WAIT_V(8); PG8_WAIT_L(0); PG8_BAR; PG8_MMA(0, 0, At, B0); PG8_MMA(0, 1, At, B1); PG8_BAR; PG8_SCHED;
            PG8_LDA(At, 0, 1); PG8_STAGE(PG8_SB(0, 0), b2, voffB); PG8_STAGE(PG8_SB(0, 1), b2 + hstep, voffB); PG8_STAGE(PG8_SA(0, 0), a2, voffA);
            PG8_WAIT_V(8); PG8_WAIT_L(0); PG8_BAR; PG8_MMA(1, 0, At, B0); PG8_MMA(1, 1, At, B1); PG8_BAR; PG8_SCHED;
            PG8_LDB(B0, 1, 0); PG8_LDB(B1, 1, 1); PG8_SCHED; PG8_LDA(At, 1, 0); PG8_STAGE(PG8_SA(0, 1), a2 + hstep, voffA);
            PG8_WAIT_V(8); PG8_WAIT_L(0); PG8_BAR; PG8_MMA(0, 0, At, B0); PG8_MMA(0, 1, At, B1); PG8_BAR; PG8_SCHED;
            PG8_LDA(At, 1, 1); PG8_STAGE(PG8_SB(1, 0), b3, voffB); PG8_STAGE(PG8_SB(1, 1), b3 + hstep, voffB); PG8_STAGE(PG8_SA(1, 0), a3, voffA);
            PG8_WAIT_V(8); PG8_WAIT_L(0); PG8_BAR; PG8_MMA(1, 0, At, B0); PG8_MMA(1, 1, At, B1); PG8_BAR; PG8_SCHED;
            } else {
            PG8_LDB(B0, 0, 0); PG8_SCHED; PG8_LDA(At, 0, 0); PG8_STAGE(PG8_SA(1, 1), a1 + hstep, voffA);
            PG8_WAIT_L(8); PG8_BAR; PG8_WAIT_L(0); PG8_MMA(0, 0, At, B0); PG8_BAR; PG8_SCHED;
            PG8_LDB(B1, 0, 1); PG8_STAGE(PG8_SB(0, 0), b2, voffB);
            PG8_BAR; PG8_WAIT_L(0); PG8_MMA(0, 1, At, B1); PG8_BAR;
            PG8_LDA(At, 0, 1); PG8_STAGE(PG8_SA(0, 0), a2, voffA);
            PG8_BAR; PG8_WAIT_L(0); PG8_MMA(1, 0, At, B0); PG8_BAR; PG8_SCHED;
            PG8_STAGE(PG8_SB(0, 1), b2 + hstep, voffB);
            PG8_WAIT_V(6); PG8_BAR; PG8_MMA(1, 1, At, B1); PG8_BAR;
            PG8_LDB(B0, 1, 0); PG8_SCHED; PG8_LDA(At, 1, 0); PG8_STAGE(PG8_SA(0, 1), a2 + hstep, voffA);
            PG8_WAIT_L(8); PG8_BAR; PG8_WAIT_L(0); PG8_MMA(0, 0, At, B0); PG8_BAR; PG8_SCHED;
            PG8_LDB(B1, 1, 1); PG8_STAGE(PG8_SB(1, 0), b3, voffB);
            PG8_BAR; PG8_WAIT_L(0); PG8_MMA(0, 1, At, B1); PG8_BAR;
            PG8_LDA(At, 1, 1); PG8_STAGE(PG8_SA(1, 0), a3, voffA);
            PG8_BAR; PG8_WAIT_L(0); PG8_MMA(1, 0, At, B0); PG8_BAR; PG8_SCHED;
            PG8_STAGE(PG8_SB(1, 1), b3 + hstep, voffB);
            PG8_WAIT_V(6); PG8_BAR; PG8_MMA(1, 1, At, B1); PG8_BAR;
            }
        }
        if constexpr (ALIGN_EPI) { if (wr == 0) PG8_BAR; }
        if constexpr (!Epi::AFTER_DRAIN) { E(acc, cur, wr, wc, fr, fq); S.done(cur); }
        if (!has_next) break;
#pragma unroll
        for (int a = 0; a < 2; ++a)
#pragma unroll
            for (int b = 0; b < 2; ++b)
#pragma unroll
                for (int m = 0; m < 4; ++m)
#pragma unroll
                    for (int n = 0; n < 2; ++n) acc[a][b][m][n] = (f32x4){0.f, 0.f, 0.f, 0.f};
        cur = nxt; cA = nA; cB = nB; ++ui;
        if constexpr (ALIGN_EPI) { if (wr == 1) PG8_BAR; }
    }
    PG8_WAIT_V(0);
    if constexpr (!ALIGN_EPI) { if (wr == 0) PG8_BAR; }
    PG8_BAR;
    if constexpr (Epi::AFTER_DRAIN) { E.fused(acc, cur, wr, wc, fr, fq, lds, wid, lane); S.done(cur); }
#undef PG8_SA
#undef PG8_SB
#undef PG8_STAGE
#undef PG8_LDA
#undef PG8_LDB
#undef PG8_MMA
#undef PG8_WAIT_V
#undef PG8_WAIT_L
#undef PG8_BAR
#undef PG8_SCHED
}
}

struct EpiInProj {
    static constexpr bool PERM = true, AFTER_DRAIN = false;
    h16* Q; float* out; const float *gq, *gk;
    __device__ __forceinline__ void operator()(const f32x4 (&acc)[2][2][4][2], const pg8::Unit& u, int wr, int wc, int fr, int fq) const {
        const int sec = u.pn >> 1;
        const int col0 = 256 * (u.pn & 1) + 64 * wc + 8 * fq;
        const int rowb = u.pm * 256 + wr * 64 + fr;
        if (sec <= 1) {
            const float* g = sec == 0 ? gq : gk; const float sc = sec == 0 ? C2 : 1.0f;
            float gv[2][8];
#pragma unroll
            for (int bj = 0; bj < 2; ++bj)
#pragma unroll
                for (int i = 0; i < 8; ++i) gv[bj][i] = g[32 * bj + 8 * fq + i] * sc;
            h16* dst = Q + (size_t)sec * ((size_t)MT * 512);
#pragma unroll
            for (int ai = 0; ai < 2; ++ai)
#pragma unroll
                for (int m = 0; m < 4; ++m) {
                    float ss = 0.f;
#pragma unroll
                    for (int bj = 0; bj < 2; ++bj)
#pragma unroll
                        for (int n = 0; n < 2; ++n) { const f32x4 x = acc[ai][bj][m][n]; ss += (x[0] * x[0] + x[1] * x[1]) + (x[2] * x[2] + x[3] * x[3]); }
                    ss += __shfl_xor(ss, 16); ss += __shfl_xor(ss, 32);
                    const float rstd = 1.0f / sqrtf(ss * (1.0f / 64.0f) + EPS);
                    const int R = rowb + 128 * ai + 16 * m;
                    float* ko = nullptr;
                    if (sec == 1) { if (R >= MP) ko = out + O_KS + (size_t)(R - MP) * DATT; else { const int b = R / LP, t = R % LP - PADF; if (t >= 0) ko = out + O_KP + ((size_t)b * LSEQ + t) * DATT; } }
#pragma unroll
                    for (int bj = 0; bj < 2; ++bj) {
                        f32x4 v0 = acc[ai][bj][m][0] * rstd, v1 = acc[ai][bj][m][1] * rstd;
                        v0[0] *= gv[bj][0]; v0[1] *= gv[bj][1]; v0[2] *= gv[bj][2]; v0[3] *= gv[bj][3]; v1[0] *= gv[bj][4]; v1[1] *= gv[bj][5]; v1[2] *= gv[bj][6]; v1[3] *= gv[bj][7];
                        const h16x8 hv = {(h16)v0[0], (h16)v0[1], (h16)v0[2], (h16)v0[3], (h16)v1[0], (h16)v1[1], (h16)v1[2], (h16)v1[3]};
                        *(h16x8*)(dst + (size_t)R * 512 + col0 + 32 * bj) = hv;
                        if (ko) { *(f32x4*)(ko + col0 + 32 * bj) = v0; *(f32x4*)(ko + col0 + 32 * bj + 4) = v1; }
                    }
                }
        } else {
            h16* dst = Q + (size_t)sec * ((size_t)MT * 512);
#pragma unroll
            for (int ai = 0; ai < 2; ++ai)
#pragma unroll
                for (int m = 0; m < 4; ++m) {
                    const int R = rowb + 128 * ai + 16 * m;
                    float* vo = nullptr;
                    if (sec == 2) { if (R >= MP) vo = out + O_VS + (size_t)(R - MP) * DATT; else { const int b = R / LP, t = R % LP - PADF; if (t >= 0) vo = out + O_VP + ((size_t)b * LSEQ + t) * DATT; } }
#pragma unroll
                    for (int bj = 0; bj < 2; ++bj) {
                        const f32x4 v0 = acc[ai][bj][m][0], v1 = acc[ai][bj][m][1];
                        const h16x8 hv = {(h16)v0[0], (h16)v0[1], (h16)v0[2], (h16)v0[3], (h16)v1[0], (h16)v1[1], (h16)v1[2], (h16)v1[3]};
                        *(h16x8*)(dst + (size_t)R * 512 + col0 + 32 * bj) = hv;
                        if (vo) { *(f32x4*)(vo + col0 + 32 * bj) = v0; *(f32x4*)(vo + col0 + 32 * bj + 4) = v1; }
                    }
                }
        }
    }
};

struct OutOrder : pg8::StaticOrder {
    __device__ __forceinline__ bool next(int i, pg8::Unit& u) const { if (!pg8::StaticOrder::next(i, u)) return false; u.pm = u.pm < 64 ? u.pm + 1 : u.pm < 128 ? u.pm + 2 : u.pm + 2; return true; }
};
struct EpiGluT {
    static constexpr bool PERM = true, AFTER_DRAIN = false;
    const h16* Z; const h16* GS; const float* bglu; h16* MIX;
    __device__ __forceinline__ void operator()(const f32x4 (&acc)[2][2][4][2], const pg8::Unit& u, int wr, int wc, int fr, int fq) const {
        const int col0 = u.pn * 256 + wc * 32 + 8 * fq, rowb = u.pm * 256 + wr * 64 + fr;
#pragma unroll
        for (int ai = 0; ai < 2; ++ai)
#pragma unroll
            for (int m = 0; m < 4; ++m) {
                const size_t R = (size_t)(rowb + 128 * ai + 16 * m);
#pragma unroll
                for (int bj = 0; bj < 2; ++bj) {
                    const int c = col0 + bj * 128;
                    const h16x8 z = *(const h16x8*)(Z + R * 512 + c), gs = *(const h16x8*)(GS + R * 512 + c);
                    const f32x4 a0 = acc[ai][bj][m][0] + *(const f32x4*)(bglu + c), a1 = acc[ai][bj][m][1] + *(const f32x4*)(bglu + c + 4);
                    h16x8 o;
#pragma unroll
                    for (int i = 0; i < 8; ++i) { const float a = i < 4 ? a0[i & 3] : a1[i & 3]; o[i] = (h16)((float)z[i] * sigmoidf_(a) * siluf_((float)gs[i])); }
                    *(h16x8*)(MIX + R * 1024 + 512 + c) = o;
                }
                asm volatile("" ::: "memory");
            }
    }
};
struct EpiOutT {
    static constexpr bool PERM = false, AFTER_DRAIN = false;
    const float* xp; const float* xs; float* out;
    __device__ __forceinline__ void operator()(const f32x4 (&acc)[2][2][4][2], const pg8::Unit& u, int wr, int wc, int fr, int fq) const {
        const int col0 = u.pn * 256 + wc * 32 + 4 * fq, rowb = u.pm * 256 + wr * 64 + fr;
#pragma unroll
        for (int ai = 0; ai < 2; ++ai)
#pragma unroll
            for (int m = 0; m < 4; ++m) {
                const int R = rowb + 128 * ai + 16 * m;
                const float* xi = nullptr; float* yo = nullptr;
                if (R >= MP) { const size_t o = (size_t)(R - MP) * DM; xi = xs + o; yo = out + O_YS + o; }
                else { const int b = R / LP, t = R % LP - PADF - NMETA; if (t >= 0) { const size_t o = ((size_t)b * SEQ + t) * DM; xi = xp + o; yo = out + O_YP + o; } }
                if (yo) {
#pragma unroll
                    for (int bj = 0; bj < 2; ++bj)
#pragma unroll
                        for (int n = 0; n < 2; ++n) { const int c = col0 + bj * 128 + n * 16; *(f32x4*)(yo + c) = *(const f32x4*)(xi + c) + acc[ai][bj][m][n]; }
                }
                asm volatile("" ::: "memory");
            }
    }
};

namespace attn {
using f32x16 = __attribute__((ext_vector_type(16))) float;
using u32x4 = __attribute__((ext_vector_type(4))) unsigned;
using u32x2 = __attribute__((ext_vector_type(2))) unsigned;
typedef short v4i16_t __attribute__((ext_vector_type(4)));
typedef __attribute__((address_space(3))) const char* lds_cptr;
constexpr int NW = 8, QBLK = 32, QB = 256, KVBLK = 64, KP = 512  , OP = 1024  ;
constexpr int NSLOT = 3, SLOTB = 8192;
constexpr int LDS_K = 0, LDS_V = NSLOT * SLOTB, LDS_WS = 2 * NSLOT * SLOTB, LDS_OST = LDS_WS + NW * 64 * 4, LDS_OFF = LDS_OST + NW * 4096  , LDS_INFO = LDS_OFF + 264 * 8, LDS_REC = LDS_INFO + 64  , LDS_BYTES = LDS_REC + 4096;
constexpr int NQB = LP / QB;
__device__ __forceinline__ int crow(int r, int hi) { return (r & 3) + 8 * (r >> 2) + 4 * hi; }
#define SBAR() __builtin_amdgcn_sched_barrier(0)
__device__ __forceinline__ void cmask(f32x16& p0, f32x16& p1, int jb, int qrel, int hi) {
    const float NEG = -INFINITY; int kb = 64 * jb + 4 * hi;
#pragma unroll
    for (int r = 0; r < 16; ++r) { int kv = kb + (r & 3) + 8 * (r >> 2); if (kv > qrel) p0[r] = NEG; if (kv + 32 > qrel) p1[r] = NEG; }
}
__device__ __forceinline__ void glds16(const void* gsrc, unsigned lds_dst) { unsigned keep;
    asm volatile("s_mov_b32 %0, m0\n\ts_mov_b32 m0, %2\n\ts_nop 0\n\tglobal_load_lds_dwordx4 %1, off\n\ts_mov_b32 m0, %0" : "=&s"(keep) : "v"(gsrc), "s"(lds_dst) : "memory"); }
__device__ __forceinline__ float max3f(float a, float b, float c) { float r; asm("v_max3_f32 %0, %1, %2, %3" : "=v"(r) : "v"(a), "v"(b), "v"(c)); return r; }
__device__ __forceinline__ float max2f(float a, float b) { float r; asm("v_max_f32_e32 %0, %1, %2" : "=v"(r) : "v"(a), "v"(b)); return r; }
__device__ __forceinline__ float fadd_s(float a, float b) { float r; asm("v_add_f32_e32 %0, %1, %2" : "=v"(r) : "v"(a), "v"(b)); return r; }
__device__ __forceinline__ float fsub_s(float a, float b) { float r; asm("v_sub_f32_e32 %0, %1, %2" : "=v"(r) : "v"(a), "v"(b)); return r; }
typedef float f32x2_t __attribute__((ext_vector_type(2))); typedef _Float16 h16x2_t __attribute__((ext_vector_type(2)));
__device__ __forceinline__ unsigned cvtpk_s(float lo, float hi) { f32x2_t v = {lo, hi}; h16x2_t b = __builtin_convertvector(v, h16x2_t); return __builtin_bit_cast(unsigned, b); }
#define WAIT_BAR_KB(N) asm volatile("s_waitcnt vmcnt(" #N ") lgkmcnt(0)\n\ts_barrier" ::: "memory")
__device__ __forceinline__ void glds4(const void* gsrc, unsigned lds_dst) { unsigned keep;
    asm volatile("s_mov_b32 %0, m0\n\ts_mov_b32 m0, %2\n\ts_nop 0\n\tglobal_load_lds_dword %1, off\n\ts_mov_b32 m0, %0" : "=&s"(keep) : "v"(gsrc), "s"(lds_dst) : "memory"); }

__device__ __forceinline__ void kload8(h16x8* kf, lds_cptr kp) {
    kf[0] = *(const LAS h16x8*)(kp);        kf[1] = *(const LAS h16x8*)(kp + 512);
    kf[2] = *(const LAS h16x8*)(kp + 2048); kf[3] = *(const LAS h16x8*)(kp + 2560);
    kf[4] = *(const LAS h16x8*)(kp + 4096); kf[5] = *(const LAS h16x8*)(kp + 4608);
    kf[6] = *(const LAS h16x8*)(kp + 6144); kf[7] = *(const LAS h16x8*)(kp + 6656);
}
__device__ __forceinline__ void kload2(h16x8* kf, lds_cptr kp, int j) { kf[2 * j] = *(const LAS h16x8*)(kp + j * 2048); kf[2 * j + 1] = *(const LAS h16x8*)(kp + j * 2048 + 512); }
__device__ __forceinline__ h16x4 vtr(lds_cptr p) { return __builtin_bit_cast(h16x4, __builtin_amdgcn_ds_read_tr16_b64_v4i16((LAS v4i16_t*)p)); }
__device__ __forceinline__ float rowmax(const f32x16& p0, const f32x16& p1) {
    float a = max3f(p0[0], p0[1], p1[0]), b = max3f(p0[2], p0[3], p1[1]); a = max3f(a, p1[2], p1[3]);
#pragma unroll
    for (int r = 4; r < 16; r += 4) { a = max3f(a, p0[r], p0[r + 1]); b = max3f(b, p0[r + 2], p0[r + 3]); a = max3f(a, p1[r], p1[r + 1]); b = max3f(b, p1[r + 2], p1[r + 3]); }
    const float m = max2f(a, b);
    auto rr = __builtin_amdgcn_permlane32_swap(__float_as_uint(m), __float_as_uint(m), false, false);
    return max2f(__uint_as_float(rr[0]), __uint_as_float(rr[1]));
}
__device__ __forceinline__ void pv(f32x16* o, int vb, h16x8 pa0, h16x8 pa1, h16x8 pa2, h16x8 pa3) {
#pragma unroll
    for (int d0 = 0; d0 < 2; ++d0) { h16x4 lo[4], hi[4];
#pragma unroll
        for (int ks = 0; ks < 4; ++ks) {
            asm volatile("ds_read_b64_tr_b16 %0,%1 offset:%c2" : "=&v"(lo[ks]) : "v"(vb), "i"(d0 * 4096 + ks * 1024) : "memory");
            asm volatile("ds_read_b64_tr_b16 %0,%1 offset:%c2" : "=&v"(hi[ks]) : "v"(vb), "i"(d0 * 4096 + ks * 1024 + 512) : "memory"); }
        asm volatile("s_waitcnt lgkmcnt(0)" ::: "memory"); SBAR();
#define PK(k) (h16x8){lo[k][0], lo[k][1], lo[k][2], lo[k][3], hi[k][0], hi[k][1], hi[k][2], hi[k][3]}
        o[d0] = __builtin_amdgcn_mfma_f32_32x32x16_f16(pa0, PK(0), o[d0], 0, 0, 0);
        o[d0] = __builtin_amdgcn_mfma_f32_32x32x16_f16(pa1, PK(1), o[d0], 0, 0, 0);
        o[d0] = __builtin_amdgcn_mfma_f32_32x32x16_f16(pa2, PK(2), o[d0], 0, 0, 0);
        o[d0] = __builtin_amdgcn_mfma_f32_32x32x16_f16(pa3, PK(3), o[d0], 0, 0, 0);
#undef PK
    }
}

template <int THRL> __device__ __forceinline__ void attn_unit(int b, int h, int qb, const h16* Q, const h16* __restrict__ K, const h16* __restrict__ V, const h16* __restrict__ GA, h16* MIX,
                                                             const double* __restrict__ anch, const char* kbt, const char* neg1, float thr, char* shm) {
    int tid_ = threadIdx.x; asm volatile("" : "+v"(tid_));
    const int tid = tid_, lane = tid & 63, r32 = lane & 31, hi = lane >> 5; const int wid = __builtin_amdgcn_readfirstlane(tid >> 6);
    volatile int* info = (volatile int*)(shm + LDS_INFO); u32x2* offrec = (u32x2*)(shm + LDS_OFF);
    const int NTabs = 4 * (qb + 1), tb0 = 4 * qb;
    const double Aref = anch[tb0];
    if (tid == 0) info[0] = tb0;
    __syncthreads();
    if (tid < tb0) { if (!((Aref - anch[tid + 1]) < -(double)thr)) atomicMin((int*)(shm + LDS_INFO), tid); }
    __syncthreads();
    const int tbeg = __builtin_amdgcn_readfirstlane(info[0]) & ~1;
    const int NT = NTabs - tbeg;
    if (tid < NT) { unsigned w0, w1; split3((float)((Aref - anch[tbeg + tid]) * 1.4426950408889634), w0, w1); u32x2 o; o[0] = w0 << 16; o[1] = (w0 >> 16) | (w1 << 16); offrec[tid] = o; }
    __syncthreads();

    const long rowbase = (long)b * LP + (long)tbeg * KVBLK; const int q0 = qb * QB - tbeg * KVBLK;
    const h16* Qw = Q + (rowbase + q0 + wid * QBLK) * KP + h * 64;
    const h16 *Kh = K + rowbase * KP + h * 64, *Vh = V + rowbase * KP + h * 64;
    const unsigned lds0 = (unsigned)(uintptr_t)shm;
    float* wsf = (float*)(shm + LDS_WS) + wid * 64;
    const h16* ksrc = Kh + (long)lane * KP + wid * 8;
    const h16* vsrc = Vh + (long)(16 * (wid & 3) + (lane >> 2)) * KP + (wid >> 2) * 32 + (lane & 3) * 8;
    const unsigned kdst = lds0 + LDS_K + wid * 1024, vdst = lds0 + LDS_V + wid * 1024;
    const bool recw = (wid & 3) < 2;
    const char* rsrc = (recw ? kbt + (long)tbeg * 1024 + (wid >> 2) * 512 + (wid & 1) * 256 : neg1) + lane * 4; const long rstep = recw ? 1024 : 0;
    const unsigned rdst = lds0 + LDS_REC + wid * 256;
    const lds_cptr rrd = (lds_cptr)shm + LDS_REC + lane * 16;
#define DMA_R(t) glds4(rsrc + (long)(t) * rstep, (unsigned)__builtin_amdgcn_readfirstlane(rdst + (((t) & 1) ? 2048u : 0u)))
#define KBREAD(t) const u32x4 kb0 = *(const LAS u32x4*)(rrd + (((t) & 1) ? 2048 : 0)), kb1 = *(const LAS u32x4*)(rrd + (((t) & 1) ? 2048 : 0) + 1024)
#define DMA_K(t, slot) glds16(ksrc + (long)(t) * KVBLK * KP, (unsigned)__builtin_amdgcn_readfirstlane(kdst + (slot)))
#define DMA_V(t, slot) glds16(vsrc + (long)(t) * KVBLK * KP, (unsigned)__builtin_amdgcn_readfirstlane(vdst + (slot)))
    const int vb0 = (int)(lds0 + LDS_V) + ((lane >> 4) & 1) * 32 + (lane & 3) * 8 + (4 * hi + ((lane & 15) >> 2)) * 64;
    h16x8 kf[8];
    const lds_cptr shm3 = (lds_cptr)shm; const lds_cptr kp0 = shm3 + LDS_K + hi * 1024 + r32 * 16; const lds_cptr vp0 = shm3 + LDS_V + ((lane >> 4) & 1) * 32 + (lane & 3) * 8 + (4 * hi + ((lane & 15) >> 2)) * 64;
    DMA_K(0, 0); DMA_V(0, 0); DMA_K(1, SLOTB);
    DMA_R(0);
    h16x8 qr[4];
#pragma unroll
    for (int d0 = 0; d0 < 4; ++d0) qr[d0] = *reinterpret_cast<const h16x8*>(&Qw[(long)r32 * KP + d0 * 16 + hi * 8]);
    float mhat = 0.f, l_reg = 0.f; f32x16 o[2]; o[0] = f32x16{}; o[1] = f32x16{};
    unsigned mw0 = 0u, mw1 = 0u;
    const int qrel = wid * QBLK + r32;
#define CMASK(P0, P1, t) do { int jb_ = (t) - (NT - 4); if (jb_ >= 0) cmask(P0, P1, jb_, qrel, hi); } while (0)
    bool resc = false;
#define QBIAS(t) const u32x2 oc_ = offrec[t]; const u32x4 qb4_ = {hi ? mw0 : 0x3C003C00u, hi ? mw1 : (0x00003C00u | oc_[0]), hi ? 0u : oc_[1], 0u}
#define QBF __builtin_bit_cast(h16x8, qb4_)
#define START(P0, P1) do { const float rm = rowmax(P0, P1); resc = false; \
    { const float dl = rm; mhat = fadd_s(mhat, dl); \
      _Pragma("unroll") for (int r = 0; r < 16; ++r) { P0[r] = fsub_s(P0[r], dl); P1[r] = fsub_s(P1[r], dl); } \
      split3(mhat, mw0, mw1); } \
    _Pragma("unroll") for (int r = 0; r < 16; ++r) P0[r] = __builtin_amdgcn_exp2f(P0[r]); } while (0)
#define RESC() do { if (resc) { asm volatile("s_waitcnt lgkmcnt(0)" ::: "memory"); \
      _Pragma("unroll") for (int d_ = 0; d_ < 2; ++d_) _Pragma("unroll") for (int r = 0; r < 16; ++r) o[d_][r] *= wsf[crow(r, hi)]; } } while (0)
    f32x16 pA0, pA1, pB0, pB1;
    int sl_prev = 0, sl_cur = 0, sl_next = SLOTB;
#define ROT() do { sl_prev = sl_cur; sl_cur = sl_next; sl_next = (sl_next == (NSLOT - 1) * SLOTB) ? 0 : sl_next + SLOTB; } while (0)
    DMA_K(2, 2 * SLOTB);
    WAIT_BAR_KB(1);
    { QBIAS(0); KBREAD(0);
      pA0 = __builtin_amdgcn_mfma_f32_32x32x16_f16(__builtin_bit_cast(h16x8, kb0), QBF, f32x16{}, 0, 0, 0);
      pA1 = __builtin_amdgcn_mfma_f32_32x32x16_f16(__builtin_bit_cast(h16x8, kb1), QBF, f32x16{}, 0, 0, 0);
      DMA_R(1);
      const lds_cptr kb = kp0;
#pragma unroll
      for (int d0 = 0; d0 < 4; ++d0) {
          const h16x8 b0 = *(const LAS h16x8*)(kb + d0 * 2048), b1 = *(const LAS h16x8*)(kb + d0 * 2048 + 512);
          pA0 = __builtin_amdgcn_mfma_f32_32x32x16_f16(b0, qr[d0], pA0, 0, 0, 0); pA1 = __builtin_amdgcn_mfma_f32_32x32x16_f16(b1, qr[d0], pA1, 0, 0, 0); } }
    asm volatile("s_nop 15\n\ts_nop 7" : "+v"(pA0), "+v"(pA1)); CMASK(pA0, pA1, 0);
    START(pA0, pA1);
    _Pragma("unroll") for (int r = 0; r < 16; ++r) pA1[r] = __builtin_amdgcn_exp2f(pA1[r]);
    WAIT_BAR_KB(0);
    DMA_K(3, 0); DMA_V(1, SLOTB);
    ROT();
    kload8(kf, kp0 + sl_cur);
    WAIT_BAR_KB(2);
    h16x4 vlo[8], vhi[8]; u32x4 pw0, pw1, pw2, pw3;
#define PKW(P, B) cvtpk_s(P[B], P[B + 1])
#define PAF(k) __builtin_bit_cast(h16x8, pw##k)
#define VFR(i) (h16x8){vlo[i][0], vlo[i][1], vlo[i][2], vlo[i][3], vhi[i][0], vhi[i][1], vhi[i][2], vhi[i][3]}
#define PIN(x) asm volatile("" : "+v"(x))
#define MX3(a, b, c) __builtin_fmaxf(__builtin_fmaxf((a), (b)), (c))
#define GAPA(MF, A0, A1, A2, A3, W0, W1, PW) do { MF; sacc += A0; sacc += A1; sacc += A2; sacc += A3; PIN(sacc); W0; W1; PIN(PW); SBAR(); } while (0)
#define EX(v) __builtin_amdgcn_exp2f(v)
#define GAPB(MF, X, B) do { MF; X[B] = EX(X[B]); X[B + 1] = EX(X[B + 1]); X[B + 2] = EX(X[B + 2]); X[B + 3] = EX(X[B + 3]); PIN(X); SBAR(); } while (0)
#define VRD(i) do { vlo[i] = vtr(vp_ + (((i) >> 2) * 4096 + ((i) & 3) * 1024)); vhi[i] = vtr(vp_ + (((i) >> 2) * 4096 + ((i) & 3) * 1024 + 512)); } while (0)
#define KRD(G, j) do { if (G) { kload2(kf, kp0 + sl_next, j); SBAR(); } } while (0)
#define MF16 __builtin_amdgcn_mfma_f32_32x32x16_f16
#define STEP(C0, C1, P0, P1, t, GK, GV, GB, GL) do { SBAR(); \
    const lds_cptr vp_ = vp0 + sl_prev; \
    { QBIAS(t); KBREAD(t); C0 = MF16(__builtin_bit_cast(h16x8, kb0), QBF, f32x16{}, 0, 0, 0); C1 = MF16(__builtin_bit_cast(h16x8, kb1), QBF, f32x16{}, 0, 0, 0); } \
    if (GB) { DMA_R((t) + 1); } \
    VRD(0); SBAR(); float sacc = (P0[0] + P0[1]); \
    GAPA(C0 = MF16(kf[0], qr[0], C0, 0, 0, 0), P0[2], P0[3], P0[4], P0[5],     pw0[0] = PKW(P0, 0), pw0[1] = PKW(P0, 2), pw0); \
    VRD(4); SBAR(); GAPA(C1 = MF16(kf[1], qr[0], C1, 0, 0, 0), P0[6], P0[7], P0[8], P0[9],     pw0[2] = PKW(P0, 4), pw0[3] = PKW(P0, 6), pw0); \
    VRD(1); SBAR(); GAPA(C0 = MF16(kf[2], qr[1], C0, 0, 0, 0), P0[10], P0[11], P0[12], P0[13], pw1[0] = PKW(P0, 8), pw1[1] = PKW(P0, 10), pw1); \
    VRD(5); SBAR(); GAPA(C1 = MF16(kf[3], qr[1], C1, 0, 0, 0), P0[14], P0[15], P1[0], P1[1],   pw1[2] = PKW(P0, 12), pw1[3] = PKW(P0, 14), pw1); \
    VRD(2); SBAR(); GAPA(C0 = MF16(kf[4], qr[2], C0, 0, 0, 0), P1[2], P1[3], P1[4], P1[5],     pw2[0] = PKW(P1, 0), pw2[1] = PKW(P1, 2), pw2); \
    VRD(6); SBAR(); GAPA(C1 = MF16(kf[5], qr[2], C1, 0, 0, 0), P1[6], P1[7], P1[8], P1[9],     pw2[2] = PKW(P1, 4), pw2[3] = PKW(P1, 6), pw2); \
    VRD(3); SBAR(); GAPA(C0 = MF16(kf[6], qr[3], C0, 0, 0, 0), P1[10], P1[11], P1[12], P1[13], pw3[0] = PKW(P1, 8), pw3[1] = PKW(P1, 10), pw3); \
    VRD(7); SBAR(); GAPA(C1 = MF16(kf[7], qr[3], C1, 0, 0, 0), P1[14], P1[15], 0.f, 0.f,       pw3[2] = PKW(P1, 12), pw3[3] = PKW(P1, 14), pw3); \
    l_reg += sacc; \
    if (GK) { DMA_K((t) + 3, sl_cur); } if (GV) { DMA_V((t) + 1, sl_next); } \
    CMASK(C0, C1, t); \
    { float a = MX3(C0[0], C0[1], C1[0]), b = MX3(C0[2], C0[3], C1[1]); a = MX3(a, C1[2], C1[3]); \
      _Pragma("unroll") for (int r = 4; r < 16; r += 4) { a = MX3(a, C0[r], C0[r + 1]); b = MX3(b, C0[r + 2], C0[r + 3]); a = MX3(a, C1[r], C1[r + 1]); b = MX3(b, C1[r + 2], C1[r + 3]); } \
      float rm = __builtin_fmaxf(a, b); { auto rr = __builtin_amdgcn_permlane32_swap(__float_as_uint(rm), __float_as_uint(rm), false, false); rm = __builtin_fmaxf(__uint_as_float(rr[0]), __uint_as_float(rr[1])); } \
      resc = false; \
      if (__builtin_expect(__any(rm > (float)THRL), 0)) { const float dl = __builtin_fmaxf(rm, 0.f); mhat += dl; \
        _Pragma("unroll") for (int r = 0; r < 16; ++r) { C0[r] -= dl; C1[r] -= dl; } \
        split3(mhat, mw0, mw1); \
        const float f = __builtin_amdgcn_exp2f(-dl); l_reg *= f; if (hi == 0) wsf[r32] = f; resc = true; } } \
    SBAR(); \
    GAPB(o[0] = MF16(PAF(0), VFR(0), o[0], 0, 0, 0), C0, 0); \
    GAPB(o[1] = MF16(PAF(0), VFR(4), o[1], 0, 0, 0), C0, 4); \
    KRD(GL, 0); GAPB(o[0] = MF16(PAF(1), VFR(1), o[0], 0, 0, 0), C0, 8); \
    KRD(GL, 1); GAPB(o[1] = MF16(PAF(1), VFR(5), o[1], 0, 0, 0), C0, 12); \
    KRD(GL, 2); GAPB(o[0] = MF16(PAF(2), VFR(2), o[0], 0, 0, 0), C1, 0); \
    KRD(GL, 3); GAPB(o[1] = MF16(PAF(2), VFR(6), o[1], 0, 0, 0), C1, 4); \
    GAPB(o[0] = MF16(PAF(3), VFR(3), o[0], 0, 0, 0), C1, 8); \
    GAPB(o[1] = MF16(PAF(3), VFR(7), o[1], 0, 0, 0), C1, 12); \
    } while (0)
    int t = 1;
#undef CMASK
#define CMASK(P0, P1, t) do { } while (0)
    for (; t + 5 < NT; t += 2) {
        STEP(pB0, pB1, pA0, pA1, t, true, true, true, true);       WAIT_BAR_KB(2); RESC(); ROT();
        STEP(pA0, pA1, pB0, pB1, t + 1, true, true, true, true);   WAIT_BAR_KB(2); RESC(); ROT();
    }
#undef CMASK
#define CMASK(P0, P1, t) do { int jb_ = (t) - (NT - 4); if (jb_ >= 0) cmask(P0, P1, jb_, qrel, hi); } while (0)
#define ENDW(tt) do { if ((tt) + 3 < NT) { WAIT_BAR_KB(2); } else if ((tt) + 2 < NT) { WAIT_BAR_KB(1); } else { WAIT_BAR_KB(0); } } while (0)
    for (; t + 1 < NT; t += 2) {
        STEP(pB0, pB1, pA0, pA1, t, (t + 3 < NT), (t + 1 < NT), (t + 1 < NT), (t + 1 < NT));         ENDW(t);     RESC(); ROT();
        STEP(pA0, pA1, pB0, pB1, t + 1, (t + 4 < NT), (t + 2 < NT), (t + 2 < NT), (t + 2 < NT));     ENDW(t + 1); RESC(); ROT();
    }
    STEP(pB0, pB1, pA0, pA1, NT - 1, false, false, false, false); RESC();
    { float sacc = pB0[0] + pB0[1]; _Pragma("unroll") for (int r = 2; r < 16; ++r) sacc += pB0[r]; _Pragma("unroll") for (int r = 0; r < 16; ++r) sacc += pB1[r]; l_reg += sacc;
      pw0 = (u32x4){PKW(pB0, 0), PKW(pB0, 2), PKW(pB0, 4), PKW(pB0, 6)}; pw1 = (u32x4){PKW(pB0, 8), PKW(pB0, 10), PKW(pB0, 12), PKW(pB0, 14)}; pw2 = (u32x4){PKW(pB1, 0), PKW(pB1, 2), PKW(pB1, 4), PKW(pB1, 6)}; pw3 = (u32x4){PKW(pB1, 8), PKW(pB1, 10), PKW(pB1, 12), PKW(pB1, 14)};
      SBAR(); pv(o, vb0 + sl_cur, PAF(0), PAF(1), PAF(2), PAF(3)); }
#undef PKW
#undef PAF
#undef VFR
#undef PIN
#undef MX3
#undef GAPA
#undef GAPB
#undef EX
#undef VRD
#undef KRD
#undef STEP
#undef ENDW
#undef MF16
    { auto rr = __builtin_amdgcn_permlane32_swap(__float_as_uint(l_reg), __float_as_uint(l_reg), false, false); l_reg = __uint_as_float(rr[0]) + __uint_as_float(rr[1]); }
    if (hi == 0) wsf[32 + r32] = l_reg; asm volatile("s_waitcnt lgkmcnt(0)" ::: "memory");
    float rli[16];
#pragma unroll
    for (int r = 0; r < 16; ++r) rli[r] = __builtin_amdgcn_rcpf(wsf[32 + crow(r, hi)]);
    const long orow0 = rowbase + q0 + wid * QBLK;
    { h16* stg = (h16*)(shm + LDS_OST) + wid * 2048;
#pragma unroll
      for (int r = 0; r < 16; ++r) { const int orow = crow(r, hi);
#pragma unroll
          for (int d0 = 0; d0 < 2; ++d0) stg[orow * 64 + d0 * 32 + r32] = (h16)(o[d0][r] * rli[r]); }
      asm volatile("s_waitcnt lgkmcnt(0)" ::: "memory");
#pragma unroll
      for (int i = 0; i < 4; ++i) { const int row = i * 8 + (lane >> 3), ch = lane & 7; const h16x8 v = *(const h16x8*)(stg + row * 64 + ch * 8);
          const h16x8 g = *(const h16x8*)(GA + (orow0 + row) * KP + h * 64 + ch * 8); h16x8 w;
#pragma unroll
          for (int e = 0; e < 8; ++e) w[e] = (h16)((float)v[e] * siluf_((float)g[e]));
          *(h16x8*)(MIX + (orow0 + row) * OP + h * 64 + ch * 8) = w; } }
    asm volatile("s_waitcnt vmcnt(0) lgkmcnt(0)\n\ts_barrier" ::: "memory");
#undef DMA_K
#undef DMA_V
#undef CMASK
#undef START
#undef RESC
#undef ROT
#undef QBF
#undef QBIAS
#undef DMA_R
#undef KBREAD
}
#undef SBAR
#undef WAIT_BAR_KB
}
__device__ __forceinline__ float skip_thr(const float* gq, const float* gk);
__device__ __forceinline__ void attn_sample_wave(const Ctx& C, int sb, int h, char* wl);
__device__ __forceinline__ void ssm_carry_thread(const Ctx& C, int gt);
__device__ __forceinline__ void attn_prompt_phase(const Ctx& C, unsigned char* lds, int qoff) {
    char* shm = (char*)lds;
    volatile int* info = (volatile int*)(shm + attn::LDS_INFO);
    for (;;) {
        if (C.tid == 0) info[1] = (int)__hip_atomic_fetch_add(C.ctl + CW_Q + qoff, 1u, __ATOMIC_RELAXED, __HIP_MEMORY_SCOPE_AGENT);
        __syncthreads();
        const int idx = __builtin_amdgcn_readfirstlane(info[1]);
        __syncthreads();
        if (idx >= 40) break;
        if (idx < 32) attn_sample_wave(C, idx, C.wave, shm + C.wave * 5376);
        else ssm_carry_thread(C, (idx - 32) * NTHREADS + C.tid);
    }
    const float thr = skip_thr(C.gq, C.gk);
    for (;;) {
        if (C.tid == 0) info[1] = (int)__hip_atomic_fetch_add(C.ctl + CW_Q + 64 + qoff, 1u, __ATOMIC_RELAXED, __HIP_MEMORY_SCOPE_AGENT);
        __syncthreads();
        const int idx = __builtin_amdgcn_readfirstlane(info[1]);
        __syncthreads();
        if (idx >= 16 * 64) break;
        const int qb = 64 - idx / 16, bh = idx % 16;
        attn::attn_unit<8>(bh >> 3, bh & 7, qb, C.Q16, C.K16, C.V16, C.GA, C.MIX, C.ANCH + bh * 264, C.KBT + (size_t)bh * 260 * 1024, C.NEG1, thr, shm);
    }
}

__device__ __forceinline__ float skip_thr(const float* gq, const float* gk) {
    float a = 0.f, b = 0.f;
    for (int d = 0; d < 64; ++d) { a = fmaxf(a, fabsf(gq[d])); b = fmaxf(b, fabsf(gk[d])); }
    return 104.0f + 2.0f * 8.0f * a * b + 1.0f;
}
__device__ __forceinline__ void attn_sample_wave(const Ctx& C, int sb, int h, char* wl) {
    int lane_ = C.lane; asm volatile("" : "+v"(lane_));
    const int lane = lane_, c16 = lane & 15, g = lane >> 4;
    float* dk = (float*)wl; float* pt = dk + 1040; float* sc = pt + 256;
    constexpr double L2E = 1.4426950408889634;
    const double* cs = C.CUMS + (size_t)sb * (PAST + DS) * 8 + h;
    const double ref = cs[(size_t)(PAST - 1) * 8];
    for (int k = lane; k < PAST + DS; k += 64) dk[k] = (float)((ref - cs[(size_t)k * 8]) * L2E);
    const float dq = (float)((cs[(size_t)(PAST + c16) * 8] - ref) * L2E);
    const size_t Rq = (size_t)MP + (size_t)sb * DS;
    const h16* qp = C.Q16 + (Rq + c16) * 512 + h * 64 + 8 * g;
    const h16x8 qf0 = *(const h16x8*)qp, qf1 = *(const h16x8*)(qp + 32);
    float m_run = -INFINITY, l_run = 0.f, o[16];
#pragma unroll
    for (int i = 0; i < 16; ++i) o[i] = 0.f;
    LDS_WAIT();
#define SAMPLE_TILE(KA0, KA1, VR, t, LAST) do { \
        f32x4 s_ = __builtin_amdgcn_mfma_f32_16x16x32_f16(KA0, qf0, (f32x4){0.f, 0.f, 0.f, 0.f}, 0, 0, 0); s_ = __builtin_amdgcn_mfma_f32_16x16x32_f16(KA1, qf1, s_, 0, 0, 0); \
        float tm_ = -INFINITY; \
        _Pragma("unroll") for (int i = 0; i < 4; ++i) { s_[i] += dq + dk[16 * (t) + 4 * g + i]; if ((LAST) && 4 * g + i > c16) s_[i] = -INFINITY; tm_ = fmaxf(tm_, s_[i]); } \
        tm_ = fmaxf(tm_, __shfl_xor(tm_, 16)); tm_ = fmaxf(tm_, __shfl_xor(tm_, 32)); \
        const float mn_ = fmaxf(m_run, tm_), scale_ = __builtin_amdgcn_exp2f(m_run - mn_); m_run = mn_; \
        float ps_ = 0.f; \
        _Pragma("unroll") for (int i = 0; i < 4; ++i) { const float p_ = __builtin_amdgcn_exp2f(s_[i] - mn_); ps_ += p_; pt[(4 * g + i) * 16 + c16] = p_; } \
        l_run = l_run * scale_ + ps_; \
        if (g == 0) sc[c16] = scale_; \
        LDS_WAIT(); \
        { const f32x4 s0_ = *(const f32x4*)&sc[0], s1_ = *(const f32x4*)&sc[4], s2_ = *(const f32x4*)&sc[8], s3_ = *(const f32x4*)&sc[12]; \
          _Pragma("unroll") for (int i = 0; i < 4; ++i) { o[i] *= s0_[i]; o[4 + i] *= s1_[i]; o[8 + i] *= s2_[i]; o[12 + i] *= s3_[i]; } } \
        _Pragma("unroll") for (int kk = 0; kk < 16; ++kk) { \
            const f32x4 p0_ = *(const f32x4*)&pt[kk * 16], p1_ = *(const f32x4*)&pt[kk * 16 + 4], p2_ = *(const f32x4*)&pt[kk * 16 + 8], p3_ = *(const f32x4*)&pt[kk * 16 + 12]; const float v_ = VR[kk]; \
            _Pragma("unroll") for (int i = 0; i < 4; ++i) { o[i] += p0_[i] * v_; o[4 + i] += p1_[i] * v_; o[8 + i] += p2_[i] * v_; o[12 + i] += p3_[i] * v_; } \
            if ((kk & 1) == 1) { asm volatile("" : "+v"(o[0]), "+v"(o[1]), "+v"(o[2]), "+v"(o[3]), "+v"(o[4]), "+v"(o[5]), "+v"(o[6]), "+v"(o[7]), "+v"(o[8]), "+v"(o[9]), "+v"(o[10]), "+v"(o[11]), "+v"(o[12]), "+v"(o[13]), "+v"(o[14]), "+v"(o[15])); __builtin_amdgcn_sched_barrier(0); } } \
        LDS_WAIT(); } while (0)
    const unsigned cbytes = (unsigned)((PAST * NH - h) * HD * 4);
    const __amdgpu_buffer_rsrc_t rk = __builtin_amdgcn_make_buffer_rsrc((void*)(C.ck + ((size_t)sb * PAST * NH + h) * HD), 0, cbytes, 0x00020000);
    const __amdgpu_buffer_rsrc_t rv = __builtin_amdgcn_make_buffer_rsrc((void*)(C.cv + ((size_t)sb * PAST * NH + h) * HD), 0, cbytes, 0x00020000);
    const __amdgpu_buffer_rsrc_t rk16 = __builtin_amdgcn_make_buffer_rsrc((void*)(C.K16 + Rq * 512 + h * 64), 0, 16 * 512 * 2, 0x00020000);
    const __amdgpu_buffer_rsrc_t rv16 = __builtin_amdgcn_make_buffer_rsrc((void*)(C.V16 + Rq * 512 + h * 64), 0, 16 * 512 * 2, 0x00020000);
    const unsigned kvo = (unsigned)((c16 * NH * HD + 8 * g) * 4), kvo16 = (unsigned)((c16 * 512 + 8 * g) * 2);
    typedef unsigned u32x4_t __attribute__((ext_vector_type(4)));
    float4 kr[4]; float vr[16];
#define SAMPLE_LOADK(KR, t) do { if ((t) < PAST / 16) { const unsigned so_ = (unsigned)(t) * (16u * NH * HD * 4u); \
            KR[0] = __builtin_bit_cast(float4, __builtin_amdgcn_raw_buffer_load_b128(rk, kvo, so_, 0)); KR[1] = __builtin_bit_cast(float4, __builtin_amdgcn_raw_buffer_load_b128(rk, kvo + 16, so_, 0)); \
            KR[2] = __builtin_bit_cast(float4, __builtin_amdgcn_raw_buffer_load_b128(rk, kvo + 128, so_, 0)); KR[3] = __builtin_bit_cast(float4, __builtin_amdgcn_raw_buffer_load_b128(rk, kvo + 144, so_, 0)); } \
        else { const h16x8 a_ = __builtin_bit_cast(h16x8, __builtin_amdgcn_raw_buffer_load_b128(rk16, kvo16, 0, 0)), b_ = __builtin_bit_cast(h16x8, __builtin_amdgcn_raw_buffer_load_b128(rk16, kvo16 + 64, 0, 0)); \
            KR[0] = make_float4((float)a_[0], (float)a_[1], (float)a_[2], (float)a_[3]); KR[1] = make_float4((float)a_[4], (float)a_[5], (float)a_[6], (float)a_[7]); \
            KR[2] = make_float4((float)b_[0], (float)b_[1], (float)b_[2], (float)b_[3]); KR[3] = make_float4((float)b_[4], (float)b_[5], (float)b_[6], (float)b_[7]); } } while (0)
#define SAMPLE_LOADV(VR, t) do { if ((t) < PAST / 16) { const unsigned so_ = (unsigned)(t) * (16u * NH * HD * 4u); \
            _Pragma("unroll") for (int kk = 0; kk < 16; ++kk) VR[kk] = __builtin_bit_cast(float, __builtin_amdgcn_raw_buffer_load_b32(rv, lane * 4, so_ + kk * (NH * HD * 4), 0)); } \
        else { _Pragma("unroll") for (int kk = 0; kk < 16; ++kk) VR[kk] = (float)__builtin_bit_cast(h16, __builtin_amdgcn_raw_buffer_load_b16(rv16, lane * 2, kk * 1024, 0)); } } while (0)
    SAMPLE_LOADK(kr, 0); SAMPLE_LOADV(vr, 0);
#pragma clang loop unroll(disable)
    for (int t = 0; t <= PAST / 16; ++t) {
        const h16x8 ka0 = {(h16)kr[0].x, (h16)kr[0].y, (h16)kr[0].z, (h16)kr[0].w, (h16)kr[1].x, (h16)kr[1].y, (h16)kr[1].z, (h16)kr[1].w};
        const h16x8 ka1 = {(h16)kr[2].x, (h16)kr[2].y, (h16)kr[2].z, (h16)kr[2].w, (h16)kr[3].x, (h16)kr[3].y, (h16)kr[3].z, (h16)kr[3].w};
        __builtin_amdgcn_sched_barrier(0);
        if (t < PAST / 16) SAMPLE_LOADK(kr, t + 1);
        __builtin_amdgcn_sched_barrier(0);
        SAMPLE_TILE(ka0, ka1, vr, t, (t == PAST / 16));
        __builtin_amdgcn_sched_barrier(0);
        if (t < PAST / 16) SAMPLE_LOADV(vr, t + 1);
        __builtin_amdgcn_sched_barrier(0);
    }
#undef SAMPLE_TILE
#undef SAMPLE_LOADK
#undef SAMPLE_LOADV
    float l = l_run; l += __shfl_xor(l, 16); l += __shfl_xor(l, 32);
    if (g == 0) sc[c16] = __builtin_amdgcn_rcpf(l);
    LDS_WAIT();
#pragma unroll
    for (int q2 = 0; q2 < 16; ++q2) dk[q2 * 64 + lane] = o[q2] * sc[q2];
    LDS_WAIT();
#pragma clang loop unroll(disable)
    for (int q2 = 0; q2 < 16; ++q2) { const float ga = (float)C.GA[(Rq + q2) * 512 + h * 64 + lane]; C.MIX[(Rq + q2) * 1024 + h * 64 + lane] = (h16)(dk[q2 * 64 + lane] * siluf_(ga)); }
    LDS_WAIT();
}

__device__ __forceinline__ void ssm_tables_b(const Ctx& C) {
    const int gt = C.gw * 64 + C.lane, NT_ = C.NGW * 64;
    for (int it = gt; it < NG * 32 * 8 * 64; it += NT_) {
        const int lane = it & 63, nb = (it >> 6) & 7, kk = (it >> 9) & 31, g = it >> 14, kq = lane >> 4;
        const int s = 2 * kk + (kq >> 1), h0 = 8 * (kq & 1), pp = 16 * nb + (lane & 15), p = pp >> 1, part = pp & 1;
        const float2 pw = C.POW[((size_t)g * 65 + (63 - s)) * NST + p]; const float inv = 1.0f / C.WSC[g];
        h16x8 o;
#pragma unroll
        for (int j = 0; j < 8; ++j) { const float2 bb = C.BBAR[(g * 64 + p) * 16 + h0 + j]; o[j] = (h16)(inv * (part ? pw.x * bb.y + pw.y * bb.x : pw.x * bb.x - pw.y * bb.y)); }
        *(h16x8*)(C.T1 + (size_t)it * 8) = o;
    }
    for (int it = gt; it < NG * 32 * 64; it += NT_) {
        const int lane = it & 63, kk = (it >> 6) & 31, g = it >> 11, kq = lane >> 4, lag = 2 * kk + (kq >> 1), h0 = 8 * (kq & 1), hp = lane & 15;
        float acc[8];
#pragma unroll
        for (int j = 0; j < 8; ++j) acc[j] = 0.f;
        for (int p = 0; p < NST; ++p) {
            const float2 pw = C.POW[((size_t)g * 65 + lag) * NST + p]; const float cr = C.cre[((size_t)g * 16 + hp) * 64 + p], ci = C.cim[((size_t)g * 16 + hp) * 64 + p];
            const float er = cr * pw.x - ci * pw.y, ei = cr * pw.y + ci * pw.x;
#pragma unroll
            for (int j = 0; j < 8; ++j) { const float2 bb = C.BBAR[(g * 64 + p) * 16 + h0 + j]; acc[j] += er * bb.x - ei * bb.y; }
        }
        const float inv = 1.0f / C.WSC[g]; h16x8 o;
#pragma unroll
        for (int j = 0; j < 8; ++j) o[j] = (h16)(acc[j] * inv);
        *(h16x8*)(C.T2 + (size_t)it * 8) = o;
    }
    for (int it = gt; it < NG * 4 * 64; it += NT_) {
        const int lane = it & 63, kk = (it >> 6) & 3, g = it >> 8, kq = lane >> 4, hp = lane & 15;
        h16x8 o;
#pragma unroll
        for (int j = 0; j < 8; ++j) { const int pp = 32 * kk + 8 * kq + j, p = pp >> 1; o[j] = (h16)((pp & 1) ? -C.cim[((size_t)g * 16 + hp) * 64 + p] : C.cre[((size_t)g * 16 + hp) * 64 + p]); }
        *(h16x8*)(C.CMF + (size_t)it * 8) = o;
    }
}
__device__ __forceinline__ void ssm_send_item(const Ctx& C, int item) {
    int lane_ = C.lane; asm volatile("" : "+v"(lane_));
    const int lane = lane_, r16 = lane & 15, kq = lane >> 4, g = item & 31, cb = item >> 5;
    const bool samp = cb >= 33;
    f32x4 acc[8];
#pragma unroll
    for (int nb = 0; nb < 8; ++nb) acc[nb] = (f32x4){0.f, 0.f, 0.f, 0.f};
    const int cg = cb * 16 + r16; const bool valid = samp || cg < NB * NCH;
    const h16* arow = samp ? C.U + ((size_t)MP + (size_t)((cb - 33) * 16 + r16) * DS) * 512 + g * 16 + 8 * (kq & 1) - (size_t)48 * 512
                           : C.U + (size_t)(valid ? cg : 0) * 64 * 512 + g * 16 + 8 * (kq & 1);
    const h16* t1 = C.T1 + (size_t)g * (32 * 8 * 64 * 8) + lane * 8;
#pragma clang loop unroll_count(2)
    for (int kk = 0; kk < 32; ++kk) {
        const int s = 2 * kk + (kq >> 1);
        h16x8 a = {0, 0, 0, 0, 0, 0, 0, 0};
        if (valid && (!samp || s >= 48)) a = *(const h16x8*)(arow + (size_t)s * 512);
#pragma unroll
        for (int nb = 0; nb < 8; ++nb) { const h16x8 b = *(const h16x8*)(t1 + (size_t)(kk * 8 + nb) * 512); acc[nb] = __builtin_amdgcn_mfma_f32_16x16x32_f16(a, b, acc[nb], 0, 0, 0); }
    }
    const float ws = C.WSC[g];
#pragma unroll
    for (int nb = 0; nb < 8; ++nb)
#pragma unroll
        for (int e = 0; e < 4; ++e) {
            const int pp = 16 * nb + r16; const float v = acc[nb][e] * ws;
            if (!samp) { const int c = cb * 16 + 4 * kq + e; if (c < NB * NCH) ((float*)C.SEND)[((size_t)c * NG + g) * 128 + pp] = v; }
            else { const int sbi = (cb - 33) * 16 + 4 * kq + e, p = pp >> 1; const size_t si = ((size_t)sbi * NG + g) * NST + p;
                const float x0r = C.sre[si], x0i = C.sim[si]; const float2 a16 = C.ABAR[2 * NG * NST + g * 64 + p];
                if (pp & 1) C.out[O_SIS + si] = v + a16.x * x0i + a16.y * x0r; else C.out[O_SRS + si] = v + a16.x * x0r - a16.y * x0i; }
        }
}
__device__ __forceinline__ void ssm_carry_thread(const Ctx& C, int gt) {
    const int b = gt >> 11, gp = gt & 2047;
    const float2 a = C.ABAR[NG * NST + gp];
    float xr = 0.f, xi = 0.f;
    static_assert(NCH % 26 == 0, "carry scan batches");
#pragma clang loop unroll(disable)
    for (int c0 = 0; c0 < NCH; c0 += 26) {
        float2 s[26];
#pragma unroll
        for (int j = 0; j < 26; ++j) s[j] = C.SEND[((size_t)(b * NCH + c0 + j)) * (NG * NST) + gp];
#pragma unroll
        for (int j = 0; j < 26; ++j) {
            C.XST[((size_t)(b * NCH + c0 + j)) * (NG * NST) + gp] = make_float2(xr, xi);
            const float nr = a.x * xr - a.y * xi + s[j].x, ni = a.x * xi + a.y * xr + s[j].y; xr = nr; xi = ni;
        }
    }
    C.out[O_SRP + (size_t)b * NG * NST + gp] = xr; C.out[O_SIP + (size_t)b * NG * NST + gp] = xi;
}
__device__ __forceinline__ void ssm_out_wg(const Ctx& C, unsigned char* lds) {
    int lane_ = C.lane; asm volatile("" : "+v"(lane_));
    const int lane = lane_, r16 = lane & 15, kq = lane >> 4;
  for (int vw = C.vcu; vw < 256; vw += C.G) {
    const int g = vw & 31, part = vw >> 5;
    __syncthreads();
    { const uint4* s2 = (const uint4*)(C.T2 + (size_t)g * (32 * 64 * 8)); const uint4* sc = (const uint4*)(C.CMF + (size_t)g * (4 * 64 * 8)); uint4* d = (uint4*)lds;
      for (int i = C.tid; i < 2048 + 256; i += NTHREADS) d[i] = i < 2048 ? s2[i] : sc[i - 2048];
      const uint4* sp = (const uint4*)(C.POW + ((size_t)g * 65 + 1) * NST); uint4* dp = (uint4*)(lds + 69632);
      for (int i = C.tid; i < 2048; i += NTHREADS) dp[i] = sp[i]; }
    h16* ut = (h16*)(lds + 36864 + C.wave * 4096);
    *(uint4*)(ut + lane * 16) = make_uint4(0u, 0u, 0u, 0u); *(uint4*)(ut + lane * 16 + 8) = make_uint4(0u, 0u, 0u, 0u);
    __syncthreads();
    const LAS char* t2l = (const LAS char*)lds + lane * 16; const LAS char* cml = (const LAS char*)lds + 32768 + lane * 16;
    const float ws = C.WSC[g], dcoef = C.dd[g * 16 + r16];
    for (int it = C.wave; it < 65 + 4; it += NWAVES) {
        const bool samp = it >= 65;
        const int cg = it * 8 + part, sb = (it - 65) * 8 + part;
        if (!samp && (cg % NCH) < 4) continue;
        const long rowbase = samp ? (long)MP + (long)sb * DS - 48 : (long)cg * 64; const int pad = samp ? 48 : 0;
        { uint4 u0 = make_uint4(0u, 0u, 0u, 0u), u1 = u0;
          if (!samp || lane >= 48) { const uint4* up = (const uint4*)(C.U + (rowbase + lane) * 512 + g * 16); u0 = up[0]; u1 = up[1]; }
          *(uint4*)(ut + (64 + lane) * 16) = u0; *(uint4*)(ut + (64 + lane) * 16 + 8) = u1; }
        float4 x0v[8];
#pragma unroll
        for (int kk = 0; kk < 4; ++kk) { const int p0 = 16 * kk + 4 * kq;
            if (samp) { const size_t si = ((size_t)sb * NG + g) * NST + p0; const float4 re = *(const float4*)(C.sre + si), im = *(const float4*)(C.sim + si);
                x0v[2 * kk] = make_float4(re.x, im.x, re.y, im.y); x0v[2 * kk + 1] = make_float4(re.z, im.z, re.w, im.w); }
            else { const float4* xp = (const float4*)(C.XST + ((size_t)cg * NG + g) * NST + p0); x0v[2 * kk] = xp[0]; x0v[2 * kk + 1] = xp[1]; } }
        const float4* powl = (const float4*)(lds + 69632);
        LDS_WAIT();
#pragma clang loop unroll(disable)
        for (int r = 0; r < 4; ++r) {
            const int t = 16 * r + r16; int pn = t + 1 - pad; pn = pn < 0 ? 0 : pn;
            f32x4 accC = {0.f, 0.f, 0.f, 0.f}, accT = {0.f, 0.f, 0.f, 0.f};
#pragma unroll
            for (int kk = 0; kk < 4; ++kk) {
                const int p0 = 16 * kk + 4 * kq; const float4* pw = powl + ((pn < 1 ? 1 : pn) - 1) * 32 + (p0 >> 1);
                const float4 w0 = pw[0], w1 = pw[1], xa0 = x0v[2 * kk], xa1 = x0v[2 * kk + 1];
                h16x8 xa;
                xa[0] = (h16)(w0.x * xa0.x - w0.y * xa0.y); xa[1] = (h16)(w0.x * xa0.y + w0.y * xa0.x); xa[2] = (h16)(w0.z * xa0.z - w0.w * xa0.w); xa[3] = (h16)(w0.z * xa0.w + w0.w * xa0.z);
                xa[4] = (h16)(w1.x * xa1.x - w1.y * xa1.y); xa[5] = (h16)(w1.x * xa1.y + w1.y * xa1.x); xa[6] = (h16)(w1.z * xa1.z - w1.w * xa1.w); xa[7] = (h16)(w1.z * xa1.w + w1.w * xa1.z);
                accC = __builtin_amdgcn_mfma_f32_16x16x32_f16(xa, *(const LAS h16x8*)(cml + kk * 1024), accC, 0, 0, 0);
            }
#pragma clang loop unroll_count(4)
            for (int kk = 0; kk < 8 * (r + 1); ++kk) {
                const h16x8 a = *(const h16x8*)(ut + (64 + t - 2 * kk - (kq >> 1)) * 16 + 8 * (kq & 1));
                accT = __builtin_amdgcn_mfma_f32_16x16x32_f16(a, *(const LAS h16x8*)(t2l + kk * 1024), accT, 0, 0, 0);
            }
#pragma unroll
            for (int e = 0; e < 4; ++e) {
                const int te = 16 * r + 4 * kq + e;
                const float u = (float)ut[(64 + te) * 16 + r16];
                const float y = accC[e] + ws * accT[e] + dcoef * u;
                const float z = y * sigmoidf_(1.5957691216057308f * (y + 0.044715f * y * y * y));
                if (!samp || te >= 48) C.Z[(rowbase + te) * 512 + g * 16 + r16] = (h16)z;
            }
        }
        LDS_WAIT();
    }
  }
}

__global__ void __launch_bounds__(NTHREADS, 2) mk_fwd(Args args) {
    extern __shared__ __attribute__((aligned(16))) unsigned char lds[];
    Ctx C;
    C.tid = threadIdx.x; C.lane = C.tid & 63; C.wave = __builtin_amdgcn_readfirstlane(C.tid >> 6);
    C.G = gridDim.x; { const int bx = blockIdx.x; C.vcu = (C.G % 8 == 0) ? (bx % 8) * (C.G / 8) + bx / 8 : bx; }
    C.gw = C.vcu * NWAVES + C.wave; C.NGW = C.G * NWAVES;
    C.xp = args.in[0]; C.xs = args.in[1]; C.ck = args.in[2]; C.cv = args.in[3]; C.clf = args.in[4]; C.sre = args.in[5]; C.sim = args.in[6]; C.meta = args.in[7];
    C.ng = args.in[8]; C.win = args.in[9]; C.bf = args.in[10]; C.gq = args.in[11]; C.gk = args.in[12]; C.are = args.in[13]; C.aim = args.in[14]; C.ldt = args.in[15];
    C.bre = args.in[16]; C.bim = args.in[17]; C.cre = args.in[18]; C.cim = args.in[19]; C.dd = args.in[20]; C.wglu = args.in[21]; C.bglu = args.in[22]; C.wout = args.in[23];
    C.out = args.out; unsigned char* ws = args.ws;
    C.WINT = (h16*)(ws + WS_WINT); C.WGLUT = (h16*)(ws + WS_WGLUT); C.WOUTT = (h16*)(ws + WS_WOUTT); C.XN = (h16*)(ws + WS_XN);
    C.LOGF = (float*)(ws + WS_LOGF); C.CUM = (double*)(ws + WS_CUM); C.CUMS = (double*)(ws + WS_CUMS); C.Q16 = (h16*)(ws + WS_Q); C.K16 = (h16*)(ws + WS_K); C.V16 = (h16*)(ws + WS_V);
    C.GA = (h16*)(ws + WS_GA); C.U = (h16*)(ws + WS_U); C.GS = (h16*)(ws + WS_GS); C.Z = (h16*)(ws + WS_Z); C.MIX = (h16*)(ws + WS_MIX);
    C.ABAR = (float2*)(ws + WS_ABAR); C.BBAR = (float2*)(ws + WS_BBAR); C.SEND = (float2*)(ws + WS_SEND); C.XST = (float2*)(ws + WS_XST);
    C.ANCH = (double*)(ws + WS_ANCH); C.KBT = (char*)(ws + WS_KBT); C.NEG1 = (char*)(ws + WS_NEG1); C.ctl = (unsigned*)(ws + WS_CTL);
    C.POW = (float2*)(ws + WS_POW); C.WSC = (float*)(ws + WS_WSC); C.T1 = (h16*)(ws + WS_T1); C.T2 = (h16*)(ws + WS_T2); C.CMF = (h16*)(ws + WS_CMF);

    for (int u = C.tid; u < (LDS_BYTES - LDSCTL_OFF) / 4; u += NTHREADS) ((LAS unsigned*)((LAS unsigned char*)lds + LDSCTL_OFF))[u] = 0u;
    __syncthreads();
    XcdBarrier bar = xcd_barrier_post((unsigned*)(ws + WS_CTL) + CW_BAR, (volatile LAS unsigned*)((LAS unsigned char*)lds + MISC_OFF) + 8);

#ifndef RPH
#define RPH -1
#endif
#define REP(k) for (int rep_ = 0; rep_ < ((RPH) == (k) ? 2 : 1); ++rep_)
    REP(0) {
    phase0(C, lds);
    xcd_barrier(bar); }
    REP(1) {
    if (C.vcu < NB * NH) cum_prompt_wg(C, lds, C.vcu >> 3, C.vcu & 7);
    for (int it = C.gw; it < DB * NH; it += C.NGW) cum_sample_wave(C, it);
    ssm_tables_b(C);
    { pg8::Gemm g{C.XN, C.WINT, MT, 3072, 1024}; pg8::StaticOrder S; S.init(MT, 3072, C.G, (int)blockIdx.x);
      EpiInProj E{C.Q16, C.out, C.gq, C.gk};
      pg8::gemm_phase<EpiInProj, pg8::StaticOrder, true, true>((PG8_LAS unsigned char*)lds, g, S, E); }
    xcd_barrier(bar); }
    REP(2) {
    for (int it = C.gw; it < 35 * NG; it += C.NGW) ssm_send_item(C, it);
    xcd_barrier(bar); }
    REP(3) {
    attn_prompt_phase(C, lds, rep_ * 128);
    xcd_barrier(bar); }
    REP(4) {
    ssm_out_wg(C, lds);
    xcd_barrier(bar); }
    REP(5) {
    { pg8::Gemm g{C.Z, C.WGLUT, MT, 512, 512}; OutOrder S; S.init(130 * 256, 512, C.G, (int)blockIdx.x);
      EpiGluT E{C.Z, C.GS, C.bglu, C.MIX};
      pg8::gemm_phase<EpiGluT, OutOrder, true, true>((PG8_LAS unsigned char*)lds, g, S, E); }
    xcd_barrier(bar); }
    REP(6) {
    { pg8::Gemm g{C.MIX, C.WOUTT, MT, 1024, 1024}; OutOrder S; S.init(130 * 256, 1024, C.G, (int)blockIdx.x);
      EpiOutT E{C.xp, C.xs, C.out};
      pg8::gemm_phase<EpiOutT, OutOrder, true, true>((PG8_LAS unsigned char*)lds, g, S, E); }
    if ((RPH) == 6) xcd_barrier(bar); }
}

extern "C" void kernel_launch(void* const* d_in, const int* in_sizes, int n_in, void* d_out, int out_size, void* d_ws, size_t ws_size, hipStream_t stream) {
    static int grid = 0;
    if (grid == 0) {
        if (n_in != 24 || (size_t)out_size != O_END || ws_size < WS_END) { fprintf(stderr, "kernel_launch: unexpected sizes n_in %d out %d ws %zu (need %zu)\n", n_in, out_size, ws_size, (size_t)WS_END); grid = -1; return; }
        int dev = 0, cus = 0, per_cu = 0;
        if (hipGetDevice(&dev) != hipSuccess || hipDeviceGetAttribute(&cus, hipDeviceAttributeMultiprocessorCount, dev) != hipSuccess) { grid = -1; return; }
        if (hipFuncSetAttribute((const void*)mk_fwd, hipFuncAttributeMaxDynamicSharedMemorySize, LDS_BYTES) != hipSuccess) { fprintf(stderr, "kernel_launch: hipFuncSetAttribute failed\n"); grid = -1; return; }
        if (hipOccupancyMaxActiveBlocksPerMultiprocessor(&per_cu, (const void*)mk_fwd, NTHREADS, LDS_BYTES) != hipSuccess || per_cu < 1) { fprintf(stderr, "kernel_launch: occupancy query says %d blocks per CU\n", per_cu); grid = -1; (void)hipGetLastError(); return; }
        grid = cus;
    }
    if (grid < 0) return;
    if (hipMemsetAsync((char*)d_ws + WS_CTL, 0, CTL_ZERO_BYTES, stream) != hipSuccess) return;
    Args a{};
    for (int i = 0; i < 24; ++i) a.in[i] = (const float*)d_in[i];
    a.out = (float*)d_out; a.ws = (unsigned char*)d_ws;
    hipLaunchKernelGGL(mk_fwd, dim3(grid), dim3(NTHREADS), LDS_BYTES, stream, a);
}
```

```cpp
#include <hip/hip_runtime.h>
#include <stdint.h>
#include <cstdio>

typedef _Float16 h16;
typedef _Float16 h16x8 __attribute__((ext_vector_type(8)));
typedef _Float16 h16x4 __attribute__((ext_vector_type(4)));
typedef float f32x4 __attribute__((ext_vector_type(4)));
#define LAS __attribute__((address_space(3)))

constexpr int DM = 1024, NB = 2, SEQ = 16384, NMETA = 16, LSEQ = SEQ + NMETA, DB = 32, DS = 16, PAST = 1024;
constexpr int NH = 8, HD = 64, DATT = 512, DSSM = 512, NG = 32, SG = 16, NST = 64, DIN = 3080;
constexpr int PADF = 240, LP = 16640;
constexpr int MP = NB * LP;
constexpr int MS = DB * DS;
constexpr int MT = MP + MS;
constexpr int NCH = LP / 64;
constexpr float EPS = 1e-6f;
constexpr int NWAVES = 8, NTHREADS = 512;

constexpr size_t O_YP = 0;
constexpr size_t O_YS = O_YP + (size_t)NB * SEQ * DM;
constexpr size_t O_KP = O_YS + (size_t)DB * DS * DM;
constexpr size_t O_VP = O_KP + (size_t)NB * LSEQ * DATT;
constexpr size_t O_FP = O_VP + (size_t)NB * LSEQ * DATT;
constexpr size_t O_SRP = O_FP + (size_t)NB * LSEQ * NH;
constexpr size_t O_SIP = O_SRP + (size_t)NB * NG * NST;
constexpr size_t O_KS = O_SIP + (size_t)NB * NG * NST;
constexpr size_t O_VS = O_KS + (size_t)DB * DS * DATT;
constexpr size_t O_FS = O_VS + (size_t)DB * DS * DATT;
constexpr size_t O_SRS = O_FS + (size_t)DB * DS * NH;
constexpr size_t O_SIS = O_SRS + (size_t)DB * NG * NST;
constexpr size_t O_END = O_SIS + (size_t)DB * NG * NST;

constexpr size_t al256(size_t x) { return (x + 255) & ~(size_t)255; }
constexpr size_t WS_CTL = 0, CTL_ZERO_BYTES = 65536;
constexpr size_t WS_WINT = CTL_ZERO_BYTES;
constexpr size_t WS_WGLUT = al256(WS_WINT + (size_t)3072 * 1024 * 2);
constexpr size_t WS_WOUTT = al256(WS_WGLUT + (size_t)512 * 512 * 2);
constexpr size_t WS_XN = al256(WS_WOUTT + (size_t)1024 * 1024 * 2);
constexpr size_t WS_LOGF = al256(WS_XN + (size_t)MT * 1024 * 2);
constexpr size_t WS_CUM = al256(WS_LOGF + (size_t)MT * 8 * 4);
constexpr size_t WS_CUMS = al256(WS_CUM + (size_t)MT * 8 * 8);
constexpr size_t WS_Q = al256(WS_CUMS + (size_t)DB * 1040 * 8 * 8);
constexpr size_t WS_K = al256(WS_Q + (size_t)MT * 512 * 2);
constexpr size_t WS_V = al256(WS_K + (size_t)MT * 512 * 2);
constexpr size_t WS_GA = al256(WS_V + (size_t)MT * 512 * 2);
constexpr size_t WS_U = al256(WS_GA + (size_t)MT * 512 * 2);
constexpr size_t WS_GS = al256(WS_U + (size_t)MT * 512 * 2);
constexpr size_t WS_Z = al256(WS_GS + (size_t)MT * 512 * 2);
constexpr size_t WS_MIX = al256(WS_Z + (size_t)MT * 512 * 2);
constexpr size_t WS_ABAR = al256(WS_MIX + (size_t)MT * 1024 * 2);
constexpr size_t WS_BBAR = al256(WS_ABAR + (size_t)3 * NG * NST * 8);
constexpr size_t WS_SEND = al256(WS_BBAR + (size_t)NG * NST * SG * 8);
constexpr size_t WS_XST = al256(WS_SEND + (size_t)NB * NCH * NG * NST * 8);
static_assert(WS_K - WS_Q == (size_t)MT * 1024 && WS_V - WS_K == (size_t)MT * 1024 && WS_GA - WS_V == (size_t)MT * 1024 && WS_U - WS_GA == (size_t)MT * 1024 && WS_GS - WS_U == (size_t)MT * 1024, "Q|K|V|GA|U|GS consecutive");
constexpr size_t WS_ANCH = al256(WS_XST + (size_t)NB * NCH * NG * NST * 8);
constexpr size_t WS_KBT = al256(WS_ANCH + (size_t)16 * 264 * 8);
constexpr size_t WS_NEG1 = al256(WS_KBT + (size_t)16 * 260 * 1024);
constexpr size_t WS_POW = al256(WS_NEG1 + 1024);
constexpr size_t WS_WSC = al256(WS_POW + (size_t)NG * 65 * NST * 8);
constexpr size_t WS_T1 = al256(WS_WSC + 256);
constexpr size_t WS_T2 = al256(WS_T1 + (size_t)NG * 32 * 8 * 64 * 16);
constexpr size_t WS_CMF = al256(WS_T2 + (size_t)NG * 32 * 64 * 16);
constexpr size_t WS_END = al256(WS_CMF + (size_t)NG * 4 * 64 * 16);
constexpr int CW_Q = 8192;
constexpr int CW_BAR = 1024;

constexpr int RING_BYTES = 143360;
constexpr int LDSCTL_OFF = RING_BYTES, MISC_OFF = LDSCTL_OFF + 320;
constexpr int LDS_BYTES = 147456;

__device__ __forceinline__ float wave_sum(float v) {
#pragma unroll
    for (int o = 32; o > 0; o >>= 1) v += __shfl_xor(v, o);
    return v;
}
__device__ __forceinline__ float sigmoidf_(float x) { return 1.0f / (1.0f + __expf(-x)); }
__device__ __forceinline__ float siluf_(float x) { return x * sigmoidf_(x); }
__device__ __forceinline__ float gelu_tanh(float y) { return 0.5f * y * (1.0f + tanhf(0.7978845608028654f * (y + 0.044715f * y * y * y))); }
#define LDS_WAIT() asm volatile("s_waitcnt lgkmcnt(0)" ::: "memory")

#define XB_TMO      128
#define XB_XCNT(j)  (256  + 64 * (j))
#define XB_XSUB(j)  (1280 + 64 * (j))
#define XB_XGEN(j)  (2304 + 64 * (j))
#define XB_TOP      3328
#define XB_TOPGEN   3392
#define XCD_BAR_WORDS 3456
#define XB_SPIN_CAP (1u << 20)
__device__ __forceinline__ unsigned xb_ld(unsigned* p)              { return __hip_atomic_load(p, __ATOMIC_RELAXED, __HIP_MEMORY_SCOPE_AGENT); }
__device__ __forceinline__ unsigned xb_add(unsigned* p, unsigned v) { return __hip_atomic_fetch_add(p, v, __ATOMIC_RELAXED, __HIP_MEMORY_SCOPE_AGENT); }
__device__ __forceinline__ unsigned xb_xcc_id() { return (unsigned)__builtin_amdgcn_s_getreg((3 << 11) | 20) & 0xFu; }
#define XB_SPIN(cond, bar) do { unsigned _sp = 0; while (cond) { __builtin_amdgcn_s_sleep(1); \
    if ((++_sp & 255u) == 0u) { if (xb_ld(&(bar)[XB_TMO])) break; if (_sp > XB_SPIN_CAP) { atomicAdd(&(bar)[XB_TMO], 1u); break; } } } } while (0)
struct XcdBarrier { unsigned* bar; unsigned x; volatile LAS unsigned* st; };
__device__ __forceinline__ XcdBarrier xcd_barrier_post(unsigned* bar, volatile LAS unsigned* st) {
    XcdBarrier b; b.bar = bar; b.x = xb_xcc_id(); b.st = st;
    if (threadIdx.x == 0) (void)xb_add(&bar[XB_XCNT(b.x)], 1u);
    return b;
}
__device__ __forceinline__ void xcd_barrier_complete(unsigned* bar, unsigned x, unsigned& nloc, unsigned& nx) {
    const unsigned G = gridDim.x * gridDim.y * gridDim.z;
    unsigned sum, cnt, mine, sp = 0u;
    for (;;) {
        sum = 0u; cnt = 0u; mine = 0u;
#pragma unroll
        for (unsigned j = 0; j < 16; ++j) { const unsigned c = xb_ld(&bar[XB_XCNT(j)]); sum += c; cnt += (c > 0u) ? 1u : 0u; mine = (j == x) ? c : mine; }
        if (sum == G) break;
        __builtin_amdgcn_s_sleep(1);
        if ((++sp & 255u) == 0u) { if (xb_ld(&bar[XB_TMO])) break; if (sp > XB_SPIN_CAP) { atomicAdd(&bar[XB_TMO], 1u); break; } }
    }
    nloc = mine > 0u ? mine : 1u; nx = cnt > 0u ? cnt : 1u;
}
__device__ __forceinline__ void xcd_barrier(const XcdBarrier& b) {
    asm volatile("s_waitcnt vmcnt(0)" ::: "memory");
    __syncthreads();
    if (threadIdx.x == 0) {
        unsigned* bar = b.bar;
        __builtin_amdgcn_s_waitcnt(0);
        unsigned nloc = b.st[0], nx = b.st[1];
        if (nloc == 0u) { xcd_barrier_complete(bar, b.x, nloc, nx); b.st[0] = nloc; b.st[1] = nx; }
        const unsigned old = xb_add(&bar[XB_XSUB(b.x)], 1u);
        const unsigned gen = old / nloc;
        if (old + 1u == (gen + 1u) * nloc) {
            __builtin_amdgcn_fence(__ATOMIC_RELEASE, "agent");
            asm volatile("s_waitcnt vmcnt(0)" ::: "memory");
            const unsigned og = xb_add(&bar[XB_TOP], 1u);
            const unsigned tg = og / nx;
            if (og + 1u == (tg + 1u) * nx) xb_add(&bar[XB_TOPGEN], 1u);
            else XB_SPIN(xb_ld(&bar[XB_TOPGEN]) == tg, bar);
            __builtin_amdgcn_fence(__ATOMIC_ACQUIRE, "agent");
            xb_add(&bar[XB_XGEN(b.x)], 1u);
            asm volatile("s_waitcnt vmcnt(0)" ::: "memory");
        } else {
            XB_SPIN(xb_ld(&bar[XB_XGEN(b.x)]) == gen, bar);
            __builtin_amdgcn_fence(__ATOMIC_ACQUIRE, "agent");
            asm volatile("s_waitcnt vmcnt(0)" ::: "memory");
        }
    }
    __syncthreads();
}

struct Args { const float* in[24]; float* out; unsigned char* ws; };
struct Ctx {
    int tid, lane, wave, vcu, G, gw, NGW;
    const float *xp, *xs, *ck, *cv, *clf, *sre, *sim, *meta, *ng, *win, *bf, *gq, *gk, *are, *aim, *ldt, *bre, *bim, *cre, *cim, *dd, *wglu, *bglu, *wout;
    float* out;
    h16 *WINT, *WGLUT, *WOUTT, *XN, *GA, *U, *GS, *Z, *MIX;
    h16 *Q16, *K16, *V16;
    float *LOGF; double *CUM, *CUMS, *ANCH; float2 *ABAR, *BBAR, *SEND, *XST, *POW; float* WSC; h16 *T1, *T2, *CMF; char *KBT, *NEG1; unsigned* ctl;
};

__device__ __forceinline__ bool row_prompt(int R, int& b, int& t) { if (R >= MP) return false; b = R / LP; t = (R % LP) - PADF; return t >= 0; }

__device__ __forceinline__ void p0_transpose_item(const float* W, int K, int ldw, h16* WT, int k0, int n0, int c0, float* scr, int lane) {
#pragma unroll 8
    for (int i = 0; i < 32; ++i) { const int kk = 2 * i + (lane >> 5); scr[kk * 33 + (lane & 31)] = W[(size_t)(k0 + kk) * ldw + c0 + (lane & 31)]; }
    LDS_WAIT();
    const int c = lane & 7;
#pragma unroll
    for (int j = 0; j < 4; ++j) { const int n = (lane >> 3) + 8 * j; const float* s = scr + (8 * c) * 33 + n;
        h16x8 o = {(h16)s[0 * 33], (h16)s[1 * 33], (h16)s[2 * 33], (h16)s[3 * 33], (h16)s[4 * 33], (h16)s[5 * 33], (h16)s[6 * 33], (h16)s[7 * 33]};
        *(h16x8*)(WT + (size_t)(n0 + n) * K + k0 + 8 * c) = o; }
    LDS_WAIT();
}
__device__ __forceinline__ void p0_tables(const Ctx& C, int idx) {
    const int g = idx >> 6, p = idx & 63;
    const double dt = exp((double)C.ldt[g]), ar = (double)C.are[idx], ai = (double)C.aim[idx];
    const double mag = exp(ar * dt), abr = mag * cos(ai * dt), abi = mag * sin(ai * dt);
    C.ABAR[idx] = make_float2((float)abr, (float)abi);
    { const double m64 = exp(64.0 * ar * dt); C.ABAR[NG * NST + idx] = make_float2((float)(m64 * cos(64.0 * ai * dt)), (float)(m64 * sin(64.0 * ai * dt))); }
    { const double m16 = exp(16.0 * ar * dt); C.ABAR[2 * NG * NST + idx] = make_float2((float)(m16 * cos(16.0 * ai * dt)), (float)(m16 * sin(16.0 * ai * dt))); }
    if (p == 0) C.WSC[g] = (float)exp2(floor(log2(dt)));
    const double den = ar * ar + ai * ai, nr = abr - 1.0, ni = abi;
    const double cr = (nr * ar + ni * ai) / den, ci = (ni * ar - nr * ai) / den;
    for (int h = 0; h < 16; ++h) {
        const double br = (double)C.bre[idx * 16 + h], bi = (double)C.bim[idx * 16 + h];
        C.BBAR[idx * 16 + h] = make_float2((float)(cr * br - ci * bi), (float)(cr * bi + ci * br));
    }
}
__device__ __forceinline__ const float* p0_row_src(const Ctx& C, int R) {
    if (R < MP) { const int b = R / LP, t = R % LP - PADF; return t < 0 ? nullptr : (t < NMETA) ? C.meta + (size_t)t * DM : C.xp + ((size_t)b * SEQ + (t - NMETA)) * DM; }
    return C.xs + (size_t)(R - MP) * DM;
}
__device__ __forceinline__ void p0_row(const Ctx& C, int R, bool has, float4 (&v)[4], const float* wf) {
    const int lane = C.lane;
    float* olf = nullptr;
    if (R < MP) { const int b = R / LP, t = R % LP - PADF; if (t >= 0) olf = C.out + O_FP + ((size_t)b * LSEQ + t) * NH; }
    else olf = C.out + O_FS + (size_t)(R - MP) * NH;
    uint2* xo = (uint2*)(C.XN + (size_t)R * DM);
    if (!has) {
#pragma unroll
        for (int j = 0; j < 4; ++j) xo[lane + 64 * j] = make_uint2(0u, 0u);
        if (lane < 8) C.LOGF[(size_t)R * 8 + lane] = 0.f;
        return;
    }
    float ss = 0.f;
#pragma unroll
    for (int j = 0; j < 4; ++j) ss += v[j].x * v[j].x + v[j].y * v[j].y + v[j].z * v[j].z + v[j].w * v[j].w;
    ss = wave_sum(ss);
    const float rstd = 1.0f / sqrtf(ss * (1.0f / DM) + EPS);
    float fl[8];
#pragma unroll
    for (int h = 0; h < 8; ++h) fl[h] = 0.f;
#pragma unroll
    for (int j = 0; j < 4; ++j) {
        const float4 gv = ((const float4*)C.ng)[lane + 64 * j];
        v[j].x *= rstd * gv.x; v[j].y *= rstd * gv.y; v[j].z *= rstd * gv.z; v[j].w *= rstd * gv.w;
        h16x4 o = {(h16)v[j].x, (h16)v[j].y, (h16)v[j].z, (h16)v[j].w};
        xo[lane + 64 * j] = __builtin_bit_cast(uint2, o);
#pragma unroll
        for (int h = 0; h < 8; ++h) { const float4 w = *(const float4*)&wf[h * 1024 + 4 * (lane + 64 * j)]; fl[h] += v[j].x * w.x + v[j].y * w.y + v[j].z * w.z + v[j].w * w.w; }
    }
    float mine = 0.f;
#pragma unroll
    for (int h = 0; h < 8; ++h) { const float s = wave_sum(fl[h]); if (lane == h) mine = s; }
    if (lane < 8) {
        const float x = mine + C.bf[lane];
        const float lf = fminf(x, 0.f) - log1pf(expf(-fabsf(x)));
        C.LOGF[(size_t)R * 8 + lane] = lf; olf[lane] = lf;
    }
}
__device__ __forceinline__ void phase0(const Ctx& C, unsigned char* lds) {
    float* wf = (float*)lds;
    float* scr = (float*)(lds + 32768 + C.wave * 8448);
    for (int i = C.tid; i < 8192; i += NTHREADS) { const int k = i >> 3, h = i & 7; wf[h * 1024 + k] = C.win[(size_t)k * DIN + 1536 + h]; }
    __syncthreads();
    constexpr int I_IN = 16 * 96, I_GLU = 8 * 16, I_OUT = 16 * 32;
    for (int it = C.gw; it < I_IN + I_GLU + I_OUT; it += C.NGW) {
        int r = it;
        if (r < I_IN) { const int kb = r / 96, nb = r % 96, n0 = 32 * nb;
            const int T = n0 >> 8, bj = (n0 >> 7) & 1, wc = (n0 >> 5) & 3, sec = T >> 1;
            const int c0 = (sec < 3 ? 512 * sec : 512 * sec + 8) + 256 * (T & 1) + 64 * wc + 32 * bj;
            p0_transpose_item(C.win, 1024, DIN, C.WINT, 64 * kb, n0, c0, scr, C.lane); continue; } r -= I_IN;
        if (r < I_GLU) { const int kb = r / 16, nb = r % 16; p0_transpose_item(C.wglu, 512, 512, C.WGLUT, 64 * kb, 32 * nb, 32 * nb, scr, C.lane); continue; } r -= I_GLU;
        { const int kb = r / 32, nb = r % 32; p0_transpose_item(C.wout, 1024, 1024, C.WOUTT, 64 * kb, 32 * nb, 32 * nb, scr, C.lane); }
    }
    for (int it = C.vcu * NTHREADS + C.tid; it < NG * 65 * NST; it += C.G * NTHREADS) {
        const int p = it & 63, n = (it >> 6) % 65, g = it / (65 * 64);
        const double dt = exp((double)C.ldt[g]), e = (double)n * dt, m = exp(e * (double)C.are[g * 64 + p]), th = e * (double)C.aim[g * 64 + p];
        C.POW[it] = make_float2((float)(m * cos(th)), (float)(m * sin(th)));
    }
    { const int gt = C.vcu * NTHREADS + C.tid; if (gt < NG * NST) p0_tables(C, gt); if (gt < 16) *(uint4*)(C.NEG1 + gt * 16) = make_uint4(0xBC00BC00u, 0x0000BC00u, 0u, 0u); }
    { float4 nx[4]; int Rn = C.gw; const float* sn = p0_row_src(C, Rn);
#pragma unroll
      for (int j = 0; j < 4; ++j) nx[j] = sn ? ((const float4*)sn)[C.lane + 64 * j] : make_float4(0.f, 0.f, 0.f, 0.f);
      while (Rn < MT) {
          const int R = Rn; const bool has = sn != nullptr; float4 v[4];
#pragma unroll
          for (int j = 0; j < 4; ++j) v[j] = nx[j];
          Rn += C.NGW; sn = Rn < MT ? p0_row_src(C, Rn) : nullptr;
          if (sn) {
#pragma unroll
              for (int j = 0; j < 4; ++j) nx[j] = ((const float4*)sn)[C.lane + 64 * j]; }
          p0_row(C, R, has, v, wf);
      } }
}

__device__ __forceinline__ void split3(float x, unsigned& w0, unsigned& w1) {
    const h16 a = (h16)x; const float r1 = x - (float)a; const h16 b = (h16)r1; const float r2 = r1 - (float)b; const h16 c = (h16)r2;
    w0 = (unsigned)__builtin_bit_cast(unsigned short, a) | ((unsigned)__builtin_bit_cast(unsigned short, b) << 16); w1 = (unsigned)__builtin_bit_cast(unsigned short, c);
}
__device__ __forceinline__ void cum_prompt_wg(const Ctx& C, unsigned char* lds, int b, int h) {
    double* part = (double*)lds;
    const size_t base = (size_t)b * LP; const int bh = b * 8 + h;
    for (int vt = C.tid; vt < 520; vt += NTHREADS) { double s = 0.0; for (int i = 0; i < 32; ++i) s += (double)C.LOGF[(base + 32 * vt + i) * 8 + h]; part[vt] = s; }
    __syncthreads();
    if (C.tid == 0) { double r = 0.0; for (int i = 0; i < 520; ++i) { const double t = part[i]; part[i] = r; r += t; } part[520] = r; }
    __syncthreads();
    const unsigned short negbig = __builtin_bit_cast(unsigned short, (h16)-60000.0f);
    for (int vt = C.tid; vt < 520; vt += NTHREADS) {
        double r = part[vt]; const int tau = vt >> 1; const double A = part[2 * tau];
        if ((vt & 1) == 0) C.ANCH[bh * 264 + tau] = A;
        for (int i = 0; i < 32; ++i) {
            const int row = 32 * vt + i; r += (double)C.LOGF[(base + row) * 8 + h]; C.CUM[(base + row) * 8 + h] = r;
            unsigned w0, w1; split3((float)((A - r) * 1.4426950408889634), w0, w1);
            if (row < PADF) { w0 = negbig; w1 = 0u; }
            *(uint4*)(C.KBT + (((size_t)bh * 260 + tau) * 64 + (row & 63)) * 16) = make_uint4(w0, w1 | 0x3C000000u, 0x3C003C00u, 0u);
        }
    }
    if (C.tid == 0) C.ANCH[bh * 264 + 260] = part[520];
    __syncthreads();
}
__device__ __forceinline__ void cum_sample_wave(const Ctx& C, int item) {
    const int sb = item >> 3, h = item & 7, lane = C.lane, s0 = lane * 17;
    float v[17]; double loc = 0.0;
#pragma unroll
    for (int j = 0; j < 17; ++j) { const int s = s0 + j;
        v[j] = s < PAST ? C.clf[((size_t)sb * PAST + s) * NH + h] : s < PAST + DS ? C.LOGF[((size_t)MP + sb * DS + (s - PAST)) * 8 + h] : 0.f; loc += (double)v[j]; }
    double incl = loc;
#pragma unroll
    for (int o = 1; o < 64; o <<= 1) { const double t = __shfl_up(incl, o); if (lane >= o) incl += t; }
    double r = incl - loc;
#pragma unroll
    for (int j = 0; j < 17; ++j) { const int s = s0 + j; r += (double)v[j]; if (s < PAST + DS) C.CUMS[((size_t)sb * (PAST + DS) + s) * 8 + h] = r; }
}

constexpr float C2 = 0.125f * 1.4426950408889634f;
namespace pg8 {
#define PG8_LAS __attribute__((address_space(3)))
constexpr int BM = 256, BK = 64, HALF = 128, HTB = HALF * BK * 2  , STAGE_BYTES = 8 * HTB, NXCD = 8, WGM = 8;

__host__ __device__ __forceinline__ int lds_byte(int r, int c) { const int st = (r >> 4) * 2 + (c >> 5), rr = r & 15, cc = c & 31, ob = rr * 64 + cc * 2; return st * 1024 + (ob ^ (((ob >> 9) & 1) << 5)); }
__host__ __device__ __forceinline__ void stage_rc(int b, int& R, int& C) { const int st = b / 1024, sb = b % 1024, swz = sb ^ (((sb >> 9) & 1) << 5); R = (st >> 1) * 16 + swz / 64; C = (st & 1) * 32 + (swz % 64) / 2; }
__host__ __device__ __forceinline__ int perm32(int rho) { const int n = rho >> 4, i = rho & 15; return 8 * (i >> 2) + 4 * n + (i & 3); }
struct Unit { int pm, pn; };
struct Gemm { const h16* A; const h16* Bt; int M, N, K; };

struct StaticOrder {
    int nM, nN, nwg, G, c;
    __host__ __device__ void init(int M, int N, int G_, int c_) { nM = M / BM; nN = N / BM; nwg = nM * nN; G = G_; c = c_; }
    __host__ __device__ bool next(int i, Unit& u) const {
        const long L = (long)i * G + c; if (L >= nwg) return false;
        int wgid = (int)L; { const int q = nwg / NXCD, r = nwg % NXCD, xcd = wgid % NXCD, off = wgid / NXCD; wgid = (xcd < r ? xcd * (q + 1) : r * (q + 1) + (xcd - r) * q) + off; }
        const int nig = WGM * nN, gid = wgid / nig, fm = gid * WGM, gsz = (nM - fm) < WGM ? (nM - fm) : WGM;
        u.pm = fm + ((wgid % nig) % gsz); u.pn = (wgid % nig) / gsz; return true;
    }
    __device__ __forceinline__ void a_ready(const Unit&) const {}
    __device__ __forceinline__ void done(const Unit&) const {}
};

template <class Epi, class Sched, bool ALIGN_EPI = false, bool SP2 = false>
__device__ __forceinline__ void gemm_phase(PG8_LAS unsigned char* lds, const Gemm g, const Sched& S, const Epi& E) {
    int tid_ = threadIdx.x; asm volatile("" : "+v"(tid_));
    const int tid = tid_, wid = __builtin_amdgcn_readfirstlane(tid >> 6), lane = tid & 63, wr = wid >> 2, wc = wid & 3, fr = lane & 15, fq = lane >> 4;
    const int K = g.K, nt = K / BK;
    unsigned voffA[2], voffB[2];
#pragma unroll
    for (int i = 0; i < 2; ++i) { int R, C; stage_rc(tid * 16 + i * 8192, R, C); const int Rb = Epi::PERM ? ((R & ~31) + perm32(R & 31)) : R;
        voffA[i] = (unsigned)(R * K + C) * 2u; voffB[i] = (unsigned)(Rb * K + C) * 2u; }
    const size_t kstep = (size_t)(BK * 2);
    const size_t hstep = (size_t)HALF * K * 2;
    const size_t tstep = 2 * hstep;
    const unsigned ldsw = (unsigned)wid * 1024u;
    const int aoff = lds_byte(wr * 64 + fr, fq * 8), boff = lds_byte(wc * 32 + fr, fq * 8);
#define PG8_SA(b, h) (((b) * 2 + (h)) * HTB)
#define PG8_SB(b, h) ((4 + (b) * 2 + (h)) * HTB)
#define PG8_STAGE(bufoff, gbase, voff) do { _Pragma("unroll") for (int _i = 0; _i < 2; ++_i) \
        __builtin_amdgcn_global_load_lds((const unsigned*)((const char*)(gbase) + (voff)[_i]), (PG8_LAS unsigned*)(lds + (bufoff) + ldsw + _i * 8192), 16, 0, 0); } while (0)
#define PG8_LDA(dst, b, h) do { _Pragma("unroll") for (int m = 0; m < 4; ++m) _Pragma("unroll") for (int k = 0; k < 2; ++k) dst[m][k] = *(const PG8_LAS h16x8*)(lds + PG8_SA(b, h) + aoff + m * 2048 + k * 1024); } while (0)
#define PG8_LDB(dst, b, h) do { _Pragma("unroll") for (int n = 0; n < 2; ++n) _Pragma("unroll") for (int k = 0; k < 2; ++k) dst[n][k] = *(const PG8_LAS h16x8*)(lds + PG8_SB(b, h) + boff + n * 2048 + k * 1024); } while (0)
#define PG8_MMA(ai, bj, At, Bt) do { __builtin_amdgcn_s_setprio(1); _Pragma("unroll") for (int m = 0; m < 4; ++m) _Pragma("unroll") for (int n = 0; n < 2; ++n) _Pragma("unroll") for (int k = 0; k < 2; ++k) \
        acc[ai][bj][m][n] = __builtin_amdgcn_mfma_f32_16x16x32_f16(Bt[n][k], At[m][k], acc[ai][bj][m][n], 0, 0, 0); __builtin_amdgcn_s_setprio(0); } while (0)
#define PG8_WAIT_V(n) asm volatile("s_waitcnt vmcnt(" #n ")" ::: "memory")
#define PG8_WAIT_L(n) asm volatile("s_waitcnt lgkmcnt(" #n ")" ::: "memory")
#define PG8_BAR __builtin_amdgcn_s_barrier()
#define PG8_SCHED __builtin_amdgcn_sched_barrier(0)
    Unit cur, nxt; int ui = 0;
    if (!S.next(0, cur)) return;
    f32x4 acc[2][2][4][2];
#pragma unroll
    for (int a = 0; a < 2; ++a)
#pragma unroll
        for (int b = 0; b < 2; ++b)
#pragma unroll
            for (int m = 0; m < 4; ++m)
#pragma unroll
                for (int n = 0; n < 2; ++n) acc[a][b][m][n] = (f32x4){0.f, 0.f, 0.f, 0.f};
    h16x8 At[4][2], B0[2][2], B1[2][2];
    const char* cA = (const char*)g.A + (size_t)cur.pm * tstep; const char* cB = (const char*)g.Bt + (size_t)cur.pn * tstep;
    S.a_ready(cur);
    if constexpr (SP2) {
        PG8_STAGE(PG8_SB(0, 0), cB, voffB); PG8_STAGE(PG8_SB(0, 1), cB + hstep, voffB); PG8_STAGE(PG8_SA(0, 0), cA, voffA); PG8_STAGE(PG8_SA(0, 1), cA + hstep, voffA);
        if (wr == 1) PG8_BAR;
        PG8_WAIT_V(2); PG8_BAR;
        PG8_STAGE(PG8_SB(1, 0), cB + kstep, voffB); PG8_STAGE(PG8_SA(1, 0), cA + kstep, voffA); PG8_STAGE(PG8_SB(1, 1), cB + hstep + kstep, voffB);
        PG8_WAIT_V(6); PG8_BAR;
    } else {
        PG8_STAGE(PG8_SB(0, 0), cB, voffB); PG8_STAGE(PG8_SA(0, 0), cA, voffA); PG8_STAGE(PG8_SB(0, 1), cB + hstep, voffB); PG8_STAGE(PG8_SA(0, 1), cA + hstep, voffA);
        if (wr == 1) PG8_BAR;
        PG8_WAIT_V(4); PG8_BAR;
        PG8_STAGE(PG8_SB(1, 0), cB + kstep, voffB); PG8_STAGE(PG8_SA(1, 0), cA + kstep, voffA); PG8_STAGE(PG8_SB(1, 1), cB + hstep + kstep, voffB);
        PG8_WAIT_V(6); PG8_BAR;
    }
    for (;;) {
        const bool has_next = S.next(ui + 1, nxt);
        const char* nA = has_next ? (const char*)g.A + (size_t)nxt.pm * tstep : cA; const char* nB = has_next ? (const char*)g.Bt + (size_t)nxt.pn * tstep : cB;
        for (int t = 0; t < nt; t += 2) {
            const bool last = (t == nt - 2);
            const char* a1 = cA + (size_t)(t + 1) * kstep;
            const char* a2 = last ? nA : cA + (size_t)(t + 2) * kstep; const char* b2 = last ? nB : cB + (size_t)(t + 2) * kstep;
            const char* a3 = a2 + kstep; const char* b3 = b2 + kstep;
            if (last && has_next) S.a_ready(nxt);
            if constexpr (SP2) {
            PG8_LDB(B0, 0, 0); PG8_LDB(B1, 0, 1); PG8_SCHED; PG8_LDA(At, 0, 0); PG8_STAGE(PG8_SA(1, 1), a1 + hstep, voffA);
            PG8_WAIT_V(8); PG8_WAIT_L(0); PG8_BAR; PG8_MMA(0, 0, At, B0); PG8_MMA(0, 1, At, B1); PG8_BAR; PG8_SCHED;
            PG8_LDA(At, 0, 1); PG8_STAGE(PG8_SB(0, 0), b2, voffB); PG8_STAGE(PG8_SB(0, 1), b2 + hstep, voffB); PG8_STAGE(PG8_SA(0, 0), a2, voffA);
            PG8_WAIT_V(8); PG8_WAIT_L(0); PG8_BAR; PG8_MMA(1, 0, At, B0); PG8_MMA(1, 1, At, B1); PG8_BAR; PG8_SCHED;
            PG8_LDB(B0, 1, 0); PG8_LDB(B1, 1, 1); PG8_SCHED; PG8_LDA(At, 1, 0); PG8_STAGE(PG8_SA(0, 1), a2 + hstep, voffA);
            PG8_WAIT_V(8); PG8_WAIT_L(0); PG8_BAR; PG8_MMA(0, 0, At, B0); PG8_MMA(0, 1, At, B1); PG8_BAR; PG8_SCHED;
            PG8_LDA(At, 1, 1); PG8_STAGE(PG8_SB(1, 0), b3, voffB); PG8_STAGE(PG8_SB(1, 1), b3 + hstep, voffB); PG8_STAGE(PG8_SA(1, 0), a3, voffA);
            PG8_WAIT_V(8); PG8_WAIT_L(0); PG8_BAR; PG8_MMA(1, 0, At, B0); PG8_MMA(1, 1, At, B1); PG8_BAR; PG8_SCHED;
            } else {
            PG8_LDB(B0, 0, 0); PG8_SCHED; PG8_LDA(At, 0, 0); PG8_STAGE(PG8_SA(1, 1), a1 + hstep, voffA);
            PG8_WAIT_L(8); PG8_BAR; PG8_WAIT_L(0); PG8_MMA(0, 0, At, B0); PG8_BAR; PG8_SCHED;
            PG8_LDB(B1, 0, 1); PG8_STAGE(PG8_SB(0, 0), b2, voffB);
            PG8_BAR; PG8_WAIT_L(0); PG8_MMA(0, 1, At, B1); PG8_BAR;
            PG8_LDA(At, 0, 1); PG8_STAGE(PG8_SA(0, 0), a2, voffA);
            PG8_BAR; PG8_WAIT_L(0); PG8_MMA(1, 0, At, B0); PG8_BAR; PG8_SCHED;
            PG8_STAGE(PG8_SB(0, 1), b2 + hstep, voffB);
            PG8_WAIT_V(6); PG8_BAR; PG8_MMA(1, 1, At, B1); PG8_BAR;
            PG8_LDB(B0, 1, 0); PG8_SCHED; PG8_LDA(At, 1, 0); PG8_STAGE(PG8_SA(0, 1), a2 + hstep, voffA);
            PG8_WAIT_L(8); PG8_BAR; PG8_WAIT_L(0); PG8_MMA(0, 0, At, B0); PG8_BAR; PG8_SCHED;
            PG8_LDB(B1, 1, 1); PG8_STAGE(PG8_SB(1, 0), b3, voffB);
            PG8_BAR; PG8_WAIT_L(0); PG8_MMA(0, 1, At, B1); PG8_BAR;
            PG8_LDA(At, 1, 1); PG8_STAGE(PG8_SA(1, 0), a3, voffA);
            PG8_BAR; PG8_WAIT_L(0); PG8_MMA(1, 0, At, B0); PG8_BAR; PG8_SCHED;
            PG8_STAGE(PG8_SB(1, 1), b3 + hstep, voffB);
            PG8_WAIT_V(6); PG8_BAR; PG8_MMA(1, 1, At, B1); PG8_BAR;
            }
        }
        if constexpr (ALIGN_EPI) { if (wr == 0) PG8_BAR; }
        if constexpr (!Epi::AFTER_DRAIN) { E(acc, cur, wr, wc, fr, fq); S.done(cur); }
        if (!has_next) break;
#pragma unroll
        for (int a = 0; a < 2; ++a)
#pragma unroll
            for (int b = 0; b < 2; ++b)
#pragma unroll
                for (int m = 0; m < 4; ++m)
#pragma unroll
                    for (int n = 0; n < 2; ++n) acc[a][b][m][n] = (f32x4){0.f, 0.f, 0.f, 0.f};
        cur = nxt; cA = nA; cB = nB; ++ui;
        if constexpr (ALIGN_EPI) { if (wr == 1) PG8_BAR; }
    }
    PG8_WAIT_V(0);
    if constexpr (!ALIGN_EPI) { if (wr == 0) PG8_BAR; }
    PG8_BAR;
    if constexpr (Epi::AFTER_DRAIN) { E.fused(acc, cur, wr, wc, fr, fq, lds, wid, lane); S.done(cur); }
#undef PG8_SA
#undef PG8_SB
#undef PG8_STAGE
#undef PG8_LDA
#undef PG8_LDB
#undef PG8_MMA
#undef PG8_WAIT_V
#undef PG8_WAIT_L
#undef PG8_BAR
#undef PG8_SCHED
}
}

struct EpiInProj {
    static constexpr bool PERM = true, AFTER_DRAIN = false;
    h16* Q; float* out; const float *gq, *gk;
    __device__ __forceinline__ void operator()(const f32x4 (&acc)[2][2][4][2], const pg8::Unit& u, int wr, int wc, int fr, int fq) const {
        const int sec = u.pn >> 1;
        const int col0 = 256 * (u.pn & 1) + 64 * wc + 8 * fq;
        const int rowb = u.pm * 256 + wr * 64 + fr;
        if (sec <= 1) {
            const float* g = sec == 0 ? gq : gk; const float sc = sec == 0 ? C2 : 1.0f;
            float gv[2][8];
#pragma unroll
            for (int bj = 0; bj < 2; ++bj)
#pragma unroll
                for (int i = 0; i < 8; ++i) gv[bj][i] = g[32 * bj + 8 * fq + i] * sc;
            h16* dst = Q + (size_t)sec * ((size_t)MT * 512);
#pragma unroll
            for (int ai = 0; ai < 2; ++ai)
#pragma unroll
                for (int m = 0; m < 4; ++m) {
                    float ss = 0.f;
#pragma unroll
                    for (int bj = 0; bj < 2; ++bj)
#pragma unroll
                        for (int n = 0; n < 2; ++n) { const f32x4 x = acc[ai][bj][m][n]; ss += (x[0] * x[0] + x[1] * x[1]) + (x[2] * x[2] + x[3] * x[3]); }
                    ss += __shfl_xor(ss, 16); ss += __shfl_xor(ss, 32);
                    const float rstd = 1.0f / sqrtf(ss * (1.0f / 64.0f) + EPS);
                    const int R = rowb + 128 * ai + 16 * m;
                    float* ko = nullptr;
                    if (sec == 1) { if (R >= MP) ko = out + O_KS + (size_t)(R - MP) * DATT; else { const int b = R / LP, t = R % LP - PADF; if (t >= 0) ko = out + O_KP + ((size_t)b * LSEQ + t) * DATT; } }
#pragma unroll
                    for (int bj = 0; bj < 2; ++bj) {
                        f32x4 v0 = acc[ai][bj][m][0] * rstd, v1 = acc[ai][bj][m][1] * rstd;
                        v0[0] *= gv[bj][0]; v0[1] *= gv[bj][1]; v0[2] *= gv[bj][2]; v0[3] *= gv[bj][3]; v1[0] *= gv[bj][4]; v1[1] *= gv[bj][5]; v1[2] *= gv[bj][6]; v1[3] *= gv[bj][7];
                        const h16x8 hv = {(h16)v0[0], (h16)v0[1], (h16)v0[2], (h16)v0[3], (h16)v1[0], (h16)v1[1], (h16)v1[2], (h16)v1[3]};
                        *(h16x8*)(dst + (size_t)R * 512 + col0 + 32 * bj) = hv;
                        if (ko) { *(f32x4*)(ko + col0 + 32 * bj) = v0; *(f32x4*)(ko + col0 + 32 * bj + 4) = v1; }
                    }
                }
        } else {
            h16* dst = Q + (size_t)sec * ((size_t)MT * 512);
#pragma unroll
            for (int ai = 0; ai < 2; ++ai)
#pragma unroll
                for (int m = 0; m < 4; ++m) {
                    const int R = rowb + 128 * ai + 16 * m;
                    float* vo = nullptr;
                    if (sec == 2) { if (R >= MP) vo = out + O_VS + (size_t)(R - MP) * DATT; else { const int b = R / LP, t = R % LP - PADF; if (t >= 0) vo = out + O_VP + ((size_t)b * LSEQ + t) * DATT; } }
#pragma unroll
                    for (int bj = 0; bj < 2; ++bj) {
                        const f32x4 v0 = acc[ai][bj][m][0], v1 = acc[ai][bj][m][1];
                        const h16x8 hv = {(h16)v0[0], (h16)v0[1], (h16)v0[2], (h16)v0[3], (h16)v1[0], (h16)v1[1], (h16)v1[2], (h16)v1[3]};
                        *(h16x8*)(dst + (size_t)R * 512 + col0 + 32 * bj) = hv;
                        if (vo) { *(f32x4*)(vo + col0 + 32 * bj) = v0; *(f32x4*)(vo + col0 + 32 * bj + 4) = v1; }
                    }
                }
        }
    }
};

struct OutOrder : pg8::StaticOrder {
    __device__ __forceinline__ bool next(int i, pg8::Unit& u) const { if (!pg8::StaticOrder::next(i, u)) return false; u.pm = u.pm < 64 ? u.pm + 1 : u.pm < 128 ? u.pm + 2 : u.pm + 2; return true; }
};
struct EpiGluT {
    static constexpr bool PERM = true, AFTER_DRAIN = false;
    const h16* Z; const h16* GS; const float* bglu; h16* MIX;
    __device__ __forceinline__ void operator()(const f32x4 (&acc)[2][2][4][2], const pg8::Unit& u, int wr, int wc, int fr, int fq) const {
        const int col0 = u.pn * 256 + wc * 32 + 8 * fq, rowb = u.pm * 256 + wr * 64 + fr;
#pragma unroll
        for (int ai = 0; ai < 2; ++ai)
#pragma unroll
            for (int m = 0; m < 4; ++m) {
                const size_t R = (size_t)(rowb + 128 * ai + 16 * m);
#pragma unroll
                for (int bj = 0; bj < 2; ++bj) {
                    const int c = col0 + bj * 128;
                    const h16x8 z = *(const h16x8*)(Z + R * 512 + c), gs = *(const h16x8*)(GS + R * 512 + c);
                    const f32x4 a0 = acc[ai][bj][m][0] + *(const f32x4*)(bglu + c), a1 = acc[ai][bj][m][1] + *(const f32x4*)(bglu + c + 4);
                    h16x8 o;
#pragma unroll
                    for (int i = 0; i < 8; ++i) { const float a = i < 4 ? a0[i & 3] : a1[i & 3]; o[i] = (h16)((float)z[i] * sigmoidf_(a) * siluf_((float)gs[i])); }
                    *(h16x8*)(MIX + R * 1024 + 512 + c) = o;
                }
                asm volatile("" ::: "memory");
            }
    }
};
struct EpiOutT {
    static constexpr bool PERM = false, AFTER_DRAIN = false;
    const float* xp; const float* xs; float* out;
    __device__ __forceinline__ void operator()(const f32x4 (&acc)[2][2][4][2], const pg8::Unit& u, int wr, int wc, int fr, int fq) const {
        const int col0 = u.pn * 256 + wc * 32 + 4 * fq, rowb = u.pm * 256 + wr * 64 + fr;
#pragma unroll
        for (int ai = 0; ai < 2; ++ai)
#pragma unroll
            for (int m = 0; m < 4; ++m) {
                const int R = rowb + 128 * ai + 16 * m;
                const float* xi = nullptr; float* yo = nullptr;
                if (R >= MP) { const size_t o = (size_t)(R - MP) * DM; xi = xs + o; yo = out + O_YS + o; }
                else { const int b = R / LP, t = R % LP - PADF - NMETA; if (t >= 0) { const size_t o = ((size_t)b * SEQ + t) * DM; xi = xp + o; yo = out + O_YP + o; } }
                if (yo) {
#pragma unroll
                    for (int bj = 0; bj < 2; ++bj)
#pragma unroll
                        for (int n = 0; n < 2; ++n) { const int c = col0 + bj * 128 + n * 16; *(f32x4*)(yo + c) = *(const f32x4*)(xi + c) + acc[ai][bj][m][n]; }
                }
                asm volatile("" ::: "memory");
            }
    }
};

namespace attn {
using f32x16 = __attribute__((ext_vector_type(16))) float;
using u32x4 = __attribute__((ext_vector_type(4))) unsigned;
using u32x2 = __attribute__((ext_vector_type(2))) unsigned;
typedef short v4i16_t __attribute__((ext_vector_type(4)));
typedef __attribute__((address_space(3))) const char* lds_cptr;
constexpr int NW = 8, QBLK = 32, QB = 256, KVBLK = 64, KP = 512  , OP = 1024  ;
constexpr int NSLOT = 3, SLOTB = 8192;
constexpr int LDS_K = 0, LDS_V = NSLOT * SLOTB, LDS_WS = 2 * NSLOT * SLOTB, LDS_OST = LDS_WS + NW * 64 * 4, LDS_OFF = LDS_OST + NW * 4096  , LDS_INFO = LDS_OFF + 264 * 8, LDS_REC = LDS_INFO + 64  , LDS_BYTES = LDS_REC + 4096;
constexpr int NQB = LP / QB;
__device__ __forceinline__ int crow(int r, int hi) { return (r & 3) + 8 * (r >> 2) + 4 * hi; }
#define SBAR() __builtin_amdgcn_sched_barrier(0)
__device__ __forceinline__ void cmask(f32x16& p0, f32x16& p1, int jb, int qrel, int hi) {
    const float NEG = -INFINITY; int kb = 64 * jb + 4 * hi;
#pragma unroll
    for (int r = 0; r < 16; ++r) { int kv = kb + (r & 3) + 8 * (r >> 2); if (kv > qrel) p0[r] = NEG; if (kv + 32 > qrel) p1[r] = NEG; }
}
__device__ __forceinline__ void glds16(const void* gsrc, unsigned lds_dst) { unsigned keep;
    asm volatile("s_mov_b32 %0, m0\n\ts_mov_b32 m0, %2\n\ts_nop 0\n\tglobal_load_lds_dwordx4 %1, off\n\ts_mov_b32 m0, %0" : "=&s"(keep) : "v"(gsrc), "s"(lds_dst) : "memory"); }
__device__ __forceinline__ float max3f(float a, float b, float c) { float r; asm("v_max3_f32 %0, %1, %2, %3" : "=v"(r) : "v"(a), "v"(b), "v"(c)); return r; }
__device__ __forceinline__ float max2f(float a, float b) { float r; asm("v_max_f32_e32 %0, %1, %2" : "=v"(r) : "v"(a), "v"(b)); return r; }
__device__ __forceinline__ float fadd_s(float a, float b) { float r; asm("v_add_f32_e32 %0, %1, %2" : "=v"(r) : "v"(a), "v"(b)); return r; }
__device__ __forceinline__ float fsub_s(float a, float b) { float r; asm("v_sub_f32_e32 %0, %1, %2" : "=v"(r) : "v"(a), "v"(b)); return r; }
typedef float f32x2_t __attribute__((ext_vector_type(2))); typedef _Float16 h16x2_t __attribute__((ext_vector_type(2)));
__device__ __forceinline__ unsigned cvtpk_s(float lo, float hi) { f32x2_t v = {lo, hi}; h16x2_t b = __builtin_convertvector(v, h16x2_t); return __builtin_bit_cast(unsigned, b); }
#define WAIT_BAR_KB(N) asm volatile("s_waitcnt vmcnt(" #N ") lgkmcnt(0)\n\ts_barrier" ::: "memory")
__device__ __forceinline__ void glds4(const void* gsrc, unsigned lds_dst) { unsigned keep;
    asm volatile("s_mov_b32 %0, m0\n\ts_mov_b32 m0, %2\n\ts_nop 0\n\tglobal_load_lds_dword %1, off\n\ts_mov_b32 m0, %0" : "=&s"(keep) : "v"(gsrc), "s"(lds_dst) : "memory"); }

__device__ __forceinline__ void kload8(h16x8* kf, lds_cptr kp) {
    kf[0] = *(const LAS h16x8*)(kp);        kf[1] = *(const LAS h16x8*)(kp + 512);
    kf[2] = *(const LAS h16x8*)(kp + 2048); kf[3] = *(const LAS h16x8*)(kp + 2560);
    kf[4] = *(const LAS h16x8*)(kp + 4096); kf[5] = *(const LAS h16x8*)(kp + 4608);
    kf[6] = *(const LAS h16x8*)(kp + 6144); kf[7] = *(const LAS h16x8*)(kp + 6656);
}
__device__ __forceinline__ void kload2(h16x8* kf, lds_cptr kp, int j) { kf[2 * j] = *(const LAS h16x8*)(kp + j * 2048); kf[2 * j + 1] = *(const LAS h16x8*)(kp + j * 2048 + 512); }
__device__ __forceinline__ h16x4 vtr(lds_cptr p) { return __builtin_bit_cast(h16x4, __builtin_amdgcn_ds_read_tr16_b64_v4i16((LAS v4i16_t*)p)); }
__device__ __forceinline__ float rowmax(const f32x16& p0, const f32x16& p1) {
    float a = max3f(p0[0], p0[1], p1[0]), b = max3f(p0[2], p0[3], p1[1]); a = max3f(a, p1[2], p1[3]);
#pragma unroll
    for (int r = 4; r < 16; r += 4) { a = max3f(a, p0[r], p0[r + 1]); b = max3f(b, p0[r + 2], p0[r + 3]); a = max3f(a, p1[r], p1[r + 1]); b = max3f(b, p1[r + 2], p1[r + 3]); }
    const float m = max2f(a, b);
    auto rr = __builtin_amdgcn_permlane32_swap(__float_as_uint(m), __float_as_uint(m), false, false);
    return max2f(__uint_as_float(rr[0]), __uint_as_float(rr[1]));
}
__device__ __forceinline__ void pv(f32x16* o, int vb, h16x8 pa0, h16x8 pa1, h16x8 pa2, h16x8 pa3) {
#pragma unroll
    for (int d0 = 0; d0 < 2; ++d0) { h16x4 lo[4], hi[4];
#pragma unroll
        for (int ks = 0; ks < 4; ++ks) {
            asm volatile("ds_read_b64_tr_b16 %0,%1 offset:%c2" : "=&v"(lo[ks]) : "v"(vb), "i"(d0 * 4096 + ks * 1024) : "memory");
            asm volatile("ds_read_b64_tr_b16 %0,%1 offset:%c2" : "=&v"(hi[ks]) : "v"(vb), "i"(d0 * 4096 + ks * 1024 + 512) : "memory"); }
        asm volatile("s_waitcnt lgkmcnt(0)" ::: "memory"); SBAR();
#define PK(k) (h16x8){lo[k][0], lo[k][1], lo[k][2], lo[k][3], hi[k][0], hi[k][1], hi[k][2], hi[k][3]}
        o[d0] = __builtin_amdgcn_mfma_f32_32x32x16_f16(pa0, PK(0), o[d0], 0, 0, 0);
        o[d0] = __builtin_amdgcn_mfma_f32_32x32x16_f16(pa1, PK(1), o[d0], 0, 0, 0);
        o[d0] = __builtin_amdgcn_mfma_f32_32x32x16_f16(pa2, PK(2), o[d0], 0, 0, 0);
        o[d0] = __builtin_amdgcn_mfma_f32_32x32x16_f16(pa3, PK(3), o[d0], 0, 0, 0);
#undef PK
    }
}

template <int THRL> __device__ __forceinline__ void attn_unit(int b, int h, int qb, const h16* Q, const h16* __restrict__ K, const h16* __restrict__ V, const h16* __restrict__ GA, h16* MIX,
                                                             const double* __restrict__ anch, const char* kbt, const char* neg1, float thr, char* shm) {
    int tid_ = threadIdx.x; asm volatile("" : "+v"(tid_));
    const int tid = tid_, lane = tid & 63, r32 = lane & 31, hi = lane >> 5; const int wid = __builtin_amdgcn_readfirstlane(tid >> 6);
    volatile int* info = (volatile int*)(shm + LDS_INFO); u32x2* offrec = (u32x2*)(shm + LDS_OFF);
    const int NTabs = 4 * (qb + 1), tb0 = 4 * qb;
    const double Aref = anch[tb0];
    if (tid == 0) info[0] = tb0;
    __syncthreads();
    if (tid < tb0) { if (!((Aref - anch[tid + 1]) < -(double)thr)) atomicMin((int*)(shm + LDS_INFO), tid); }
    __syncthreads();
    const int tbeg = __builtin_amdgcn_readfirstlane(info[0]) & ~1;
    const int NT = NTabs - tbeg;
    if (tid < NT) { unsigned w0, w1; split3((float)((Aref - anch[tbeg + tid]) * 1.4426950408889634), w0, w1); u32x2 o; o[0] = w0 << 16; o[1] = (w0 >> 16) | (w1 << 16); offrec[tid] = o; }
    __syncthreads();

    const long rowbase = (long)b * LP + (long)tbeg * KVBLK; const int q0 = qb * QB - tbeg * KVBLK;
    const h16* Qw = Q + (rowbase + q0 + wid * QBLK) * KP + h * 64;
    const h16 *Kh = K + rowbase * KP + h * 64, *Vh = V + rowbase * KP + h * 64;
    const unsigned lds0 = (unsigned)(uintptr_t)shm;
    float* wsf = (float*)(shm + LDS_WS) + wid * 64;
    const h16* ksrc = Kh + (long)lane * KP + wid * 8;
    const h16* vsrc = Vh + (long)(16 * (wid & 3) + (lane >> 2)) * KP + (wid >> 2) * 32 + (lane & 3) * 8;
    const unsigned kdst = lds0 + LDS_K + wid * 1024, vdst = lds0 + LDS_V + wid * 1024;
    const bool recw = (wid & 3) < 2;
    const char* rsrc = (recw ? kbt + (long)tbeg * 1024 + (wid >> 2) * 512 + (wid & 1) * 256 : neg1) + lane * 4; const long rstep = recw ? 1024 : 0;
    const unsigned rdst = lds0 + LDS_REC + wid * 256;
    const lds_cptr rrd = (lds_cptr)shm + LDS_REC + lane * 16;
#define DMA_R(t) glds4(rsrc + (long)(t) * rstep, (unsigned)__builtin_amdgcn_readfirstlane(rdst + (((t) & 1) ? 2048u : 0u)))
#define KBREAD(t) const u32x4 kb0 = *(const LAS u32x4*)(rrd + (((t) & 1) ? 2048 : 0)), kb1 = *(const LAS u32x4*)(rrd + (((t) & 1) ? 2048 : 0) + 1024)
#define DMA_K(t, slot) glds16(ksrc + (long)(t) * KVBLK * KP, (unsigned)__builtin_amdgcn_readfirstlane(kdst + (slot)))
#define DMA_V(t, slot) glds16(vsrc + (long)(t) * KVBLK * KP, (unsigned)__builtin_amdgcn_readfirstlane(vdst + (slot)))
    const int vb0 = (int)(lds0 + LDS_V) + ((lane >> 4) & 1) * 32 + (lane & 3) * 8 + (4 * hi + ((lane & 15) >> 2)) * 64;
    h16x8 kf[8];
    const lds_cptr shm3 = (lds_cptr)shm; const lds_cptr kp0 = shm3 + LDS_K + hi * 1024 + r32 * 16; const lds_cptr vp0 = shm3 + LDS_V + ((lane >> 4) & 1) * 32 + (lane & 3) * 8 + (4 * hi + ((lane & 15) >> 2)) * 64;
    DMA_K(0, 0); DMA_V(0, 0); DMA_K(1, SLOTB);
    DMA_R(0);
    h16x8 qr[4];
#pragma unroll
    for (int d0 = 0; d0 < 4; ++d0) qr[d0] = *reinterpret_cast<const h16x8*>(&Qw[(long)r32 * KP + d0 * 16 + hi * 8]);
    float mhat = 0.f, l_reg = 0.f; f32x16 o[2]; o[0] = f32x16{}; o[1] = f32x16{};
    unsigned mw0 = 0u, mw1 = 0u;
    const int qrel = wid * QBLK + r32;
#define CMASK(P0, P1, t) do { int jb_ = (t) - (NT - 4); if (jb_ >= 0) cmask(P0, P1, jb_, qrel, hi); } while (0)
    bool resc = false;
#define QBIAS(t) const u32x2 oc_ = offrec[t]; const u32x4 qb4_ = {hi ? mw0 : 0x3C003C00u, hi ? mw1 : (0x00003C00u | oc_[0]), hi ? 0u : oc_[1], 0u}
#define QBF __builtin_bit_cast(h16x8, qb4_)
#define START(P0, P1) do { const float rm = rowmax(P0, P1); resc = false; \
    { const float dl = rm; mhat = fadd_s(mhat, dl); \
      _Pragma("unroll") for (int r = 0; r < 16; ++r) { P0[r] = fsub_s(P0[r], dl); P1[r] = fsub_s(P1[r], dl); } \
      split3(mhat, mw0, mw1); } \
    _Pragma("unroll") for (int r = 0; r < 16; ++r) P0[r] = __builtin_amdgcn_exp2f(P0[r]); } while (0)
#define RESC() do { if (resc) { asm volatile("s_waitcnt lgkmcnt(0)" ::: "memory"); \
      _Pragma("unroll") for (int d_ = 0; d_ < 2; ++d_) _Pragma("unroll") for (int r = 0; r < 16; ++r) o[d_][r] *= wsf[crow(r, hi)]; } } while (0)
    f32x16 pA0, pA1, pB0, pB1;
    int sl_prev = 0, sl_cur = 0, sl_next = SLOTB;
#define ROT() do { sl_prev = sl_cur; sl_cur = sl_next; sl_next = (sl_next == (NSLOT - 1) * SLOTB) ? 0 : sl_next + SLOTB; } while (0)
    DMA_K(2, 2 * SLOTB);
    WAIT_BAR_KB(1);
    { QBIAS(0); KBREAD(0);
      pA0 = __builtin_amdgcn_mfma_f32_32x32x16_f16(__builtin_bit_cast(h16x8, kb0), QBF, f32x16{}, 0, 0, 0);
      pA1 = __builtin_amdgcn_mfma_f32_32x32x16_f16(__builtin_bit_cast(h16x8, kb1), QBF, f32x16{}, 0, 0, 0);
      DMA_R(1);
      const lds_cptr kb = kp0;
#pragma unroll
      for (int d0 = 0; d0 < 4; ++d0) {
          const h16x8 b0 = *(const LAS h16x8*)(kb + d0 * 2048), b1 = *(const LAS h16x8*)(kb + d0 * 2048 + 512);
          pA0 = __builtin_amdgcn_mfma_f32_32x32x16_f16(b0, qr[d0], pA0, 0, 0, 0); pA1 = __builtin_amdgcn_mfma_f32_32x32x16_f16(b1, qr[d0], pA1, 0, 0, 0); } }
    asm volatile("s_nop 15\n\ts_nop 7" : "+v"(pA0), "+v"(pA1)); CMASK(pA0, pA1, 0);
    START(pA0, pA1);
    _Pragma("unroll") for (int r = 0; r < 16; ++r) pA1[r] = __builtin_amdgcn_exp2f(pA1[r]);
    WAIT_BAR_KB(0);
    DMA_K(3, 0); DMA_V(1, SLOTB);
    ROT();
    kload8(kf, kp0 + sl_cur);
    WAIT_BAR_KB(2);
    h16x4 vlo[8], vhi[8]; u32x4 pw0, pw1, pw2, pw3;
#define PKW(P, B) cvtpk_s(P[B], P[B + 1])
#define PAF(k) __builtin_bit_cast(h16x8, pw##k)
#define VFR(i) (h16x8){vlo[i][0], vlo[i][1], vlo[i][2], vlo[i][3], vhi[i][0], vhi[i][1], vhi[i][2], vhi[i][3]}
#define PIN(x) asm volatile("" : "+v"(x))
#define MX3(a, b, c) __builtin_fmaxf(__builtin_fmaxf((a), (b)), (c))
#define GAPA(MF, A0, A1, A2, A3, W0, W1, PW) do { MF; sacc += A0; sacc += A1; sacc += A2; sacc += A3; PIN(sacc); W0; W1; PIN(PW); SBAR(); } while (0)
#define EX(v) __builtin_amdgcn_exp2f(v)
#define GAPB(MF, X, B) do { MF; X[B] = EX(X[B]); X[B + 1] = EX(X[B + 1]); X[B + 2] = EX(X[B + 2]); X[B + 3] = EX(X[B + 3]); PIN(X); SBAR(); } while (0)
#define VRD(i) do { vlo[i] = vtr(vp_ + (((i) >> 2) * 4096 + ((i) & 3) * 1024)); vhi[i] = vtr(vp_ + (((i) >> 2) * 4096 + ((i) & 3) * 1024 + 512)); } while (0)
#define KRD(G, j) do { if (G) { kload2(kf, kp0 + sl_next, j); SBAR(); } } while (0)
#define MF16 __builtin_amdgcn_mfma_f32_32x32x16_f16
#define STEP(C0, C1, P0, P1, t, GK, GV, GB, GL) do { SBAR(); \
    const lds_cptr vp_ = vp0 + sl_prev; \
    { QBIAS(t); KBREAD(t); C0 = MF16(__builtin_bit_cast(h16x8, kb0), QBF, f32x16{}, 0, 0, 0); C1 = MF16(__builtin_bit_cast(h16x8, kb1), QBF, f32x16{}, 0, 0, 0); } \
    if (GB) { DMA_R((t) + 1); } \
    VRD(0); SBAR(); float sacc = (P0[0] + P0[1]); \
    GAPA(C0 = MF16(kf[0], qr[0], C0, 0, 0, 0), P0[2], P0[3], P0[4], P0[5],     pw0[0] = PKW(P0, 0), pw0[1] = PKW(P0, 2), pw0); \
    VRD(4); SBAR(); GAPA(C1 = MF16(kf[1], qr[0], C1, 0, 0, 0), P0[6], P0[7], P0[8], P0[9],     pw0[2] = PKW(P0, 4), pw0[3] = PKW(P0, 6), pw0); \
    VRD(1); SBAR(); GAPA(C0 = MF16(kf[2], qr[1], C0, 0, 0, 0), P0[10], P0[11], P0[12], P0[13], pw1[0] = PKW(P0, 8), pw1[1] = PKW(P0, 10), pw1); \
    VRD(5); SBAR(); GAPA(C1 = MF16(kf[3], qr[1], C1, 0, 0, 0), P0[14], P0[15], P1[0], P1[1],   pw1[2] = PKW(P0, 12), pw1[3] = PKW(P0, 14), pw1); \
    VRD(2); SBAR(); GAPA(C0 = MF16(kf[4], qr[2], C0, 0, 0, 0), P1[2], P1[3], P1[4], P1[5],     pw2[0] = PKW(P1, 0), pw2[1] = PKW(P1, 2), pw2); \
    VRD(6); SBAR(); GAPA(C1 = MF16(kf[5], qr[2], C1, 0, 0, 0), P1[6], P1[7], P1[8], P1[9],     pw2[2] = PKW(P1, 4), pw2[3] = PKW(P1, 6), pw2); \
    VRD(3); SBAR(); GAPA(C0 = MF16(kf[6], qr[3], C0, 0, 0, 0), P1[10], P1[11], P1[12], P1[13], pw3[0] = PKW(P1, 8), pw3[1] = PKW(P1, 10), pw3); \
    VRD(7); SBAR(); GAPA(C1 = MF16(kf[7], qr[3], C1, 0, 0, 0), P1[14], P1[15], 0.f, 0.f,       pw3[2] = PKW(P1, 12), pw3[3] = PKW(P1, 14), pw3); \
    l_reg += sacc; \
    if (GK) { DMA_K((t) + 3, sl_cur); } if (GV) { DMA_V((t) + 1, sl_next); } \
    CMASK(C0, C1, t); \
    { float a = MX3(C0[0], C0[1], C1[0]), b = MX3(C0[2], C0[3], C1[1]); a = MX3(a, C1[2], C1[3]); \
      _Pragma("unroll") for (int r = 4; r < 16; r += 4) { a = MX3(a, C0[r], C0[r + 1]); b = MX3(b, C0[r + 2], C0[r + 3]); a = MX3(a, C1[r], C1[r + 1]); b = MX3(b, C1[r + 2], C1[r + 3]); } \
      float rm = __builtin_fmaxf(a, b); { auto rr = __builtin_amdgcn_permlane32_swap(__float_as_uint(rm), __float_as_uint(rm), false, false); rm = __builtin_fmaxf(__uint_as_float(rr[0]), __uint_as_float(rr[1])); } \
      resc = false; \
      if (__builtin_expect(__any(rm > (float)THRL), 0)) { const float dl = __builtin_fmaxf(rm, 0.f); mhat += dl; \
        _Pragma("unroll") for (int r = 0; r < 16; ++r) { C0[r] -= dl; C1[r] -= dl; } \
        split3(mhat, mw0, mw1); \
        const float f = __builtin_amdgcn_exp2f(-dl); l_reg *= f; if (hi == 0) wsf[r32] = f; resc = true; } } \
    SBAR(); \
    GAPB(o[0] = MF16(PAF(0), VFR(0), o[0], 0, 0, 0), C0, 0); \
    GAPB(o[1] = MF16(PAF(0), VFR(4), o[1], 0, 0, 0), C0, 4); \
    KRD(GL, 0); GAPB(o[0] = MF16(PAF(1), VFR(1), o[0], 0, 0, 0), C0, 8); \
    KRD(GL, 1); GAPB(o[1] = MF16(PAF(1), VFR(5), o[1], 0, 0, 0), C0, 12); \
    KRD(GL, 2); GAPB(o[0] = MF16(PAF(2), VFR(2), o[0], 0, 0, 0), C1, 0); \
    KRD(GL, 3); GAPB(o[1] = MF16(PAF(2), VFR(6), o[1], 0, 0, 0), C1, 4); \
    GAPB(o[0] = MF16(PAF(3), VFR(3), o[0], 0, 0, 0), C1, 8); \
    GAPB(o[1] = MF16(PAF(3), VFR(7), o[1], 0, 0, 0), C1, 12); \
    } while (0)
    int t = 1;
#undef CMASK
#define CMASK(P0, P1, t) do { } while (0)
    for (; t + 5 < NT; t += 2) {
        STEP(pB0, pB1, pA0, pA1, t, true, true, true, true);       WAIT_BAR_KB(2); RESC(); ROT();
        STEP(pA0, pA1, pB0, pB1, t + 1, true, true, true, true);   WAIT_BAR_KB(2); RESC(); ROT();
    }
#undef CMASK
#define CMASK(P0, P1, t) do { int jb_ = (t) - (NT - 4); if (jb_ >= 0) cmask(P0, P1, jb_, qrel, hi); } while (0)
#define ENDW(tt) do { if ((tt) + 3 < NT) { WAIT_BAR_KB(2); } else if ((tt) + 2 < NT) { WAIT_BAR_KB(1); } else { WAIT_BAR_KB(0); } } while (0)
    for (; t + 1 < NT; t += 2) {
        STEP(pB0, pB1, pA0, pA1, t, (t + 3 < NT), (t + 1 < NT), (t + 1 < NT), (t + 1 < NT));         ENDW(t);     RESC(); ROT();
        STEP(pA0, pA1, pB0, pB1, t + 1, (t + 4 < NT), (t + 2 < NT), (t + 2 < NT), (t + 2 < NT));     ENDW(t + 1); RESC(); ROT();
    }
    STEP(pB0, pB1, pA0, pA1, NT - 1, false, false, false, false); RESC();
    { float sacc = pB0[0] + pB0[1]; _Pragma("unroll") for (int r = 2; r < 16; ++r) sacc += pB0[r]; _Pragma("unroll") for (int r = 0; r < 16; ++r) sacc += pB1[r]; l_reg += sacc;
      pw0 = (u32x4){PKW(pB0, 0), PKW(pB0, 2), PKW(pB0, 4), PKW(pB0, 6)}; pw1 = (u32x4){PKW(pB0, 8), PKW(pB0, 10), PKW(pB0, 12), PKW(pB0, 14)}; pw2 = (u32x4){PKW(pB1, 0), PKW(pB1, 2), PKW(pB1, 4), PKW(pB1, 6)}; pw3 = (u32x4){PKW(pB1, 8), PKW(pB1, 10), PKW(pB1, 12), PKW(pB1, 14)};
      SBAR(); pv(o, vb0 + sl_cur, PAF(0), PAF(1), PAF(2), PAF(3)); }
#undef PKW
#undef PAF
#undef VFR
#undef PIN
#undef MX3
#undef GAPA
#undef GAPB
#undef EX
#undef VRD
#undef KRD
#undef STEP
#undef ENDW
#undef MF16
    { auto rr = __builtin_amdgcn_permlane32_swap(__float_as_uint(l_reg), __float_as_uint(l_reg), false, false); l_reg = __uint_as_float(rr[0]) + __uint_as_float(rr[1]); }
    if (hi == 0) wsf[32 + r32] = l_reg; asm volatile("s_waitcnt lgkmcnt(0)" ::: "memory");
    float rli[16];
#pragma unroll
    for (int r = 0; r < 16; ++r) rli[r] = __builtin_amdgcn_rcpf(wsf[32 + crow(r, hi)]);
    const long orow0 = rowbase + q0 + wid * QBLK;
    { h16* stg = (h16*)(shm + LDS_OST) + wid * 2048;
#pragma unroll
      for (int r = 0; r < 16; ++r) { const int orow = crow(r, hi);
#pragma unroll
          for (int d0 = 0; d0 < 2; ++d0) stg[orow * 64 + d0 * 32 + r32] = (h16)(o[d0][r] * rli[r]); }
      asm volatile("s_waitcnt lgkmcnt(0)" ::: "memory");
#pragma unroll
      for (int i = 0; i < 4; ++i) { const int row = i * 8 + (lane >> 3), ch = lane & 7; const h16x8 v = *(const h16x8*)(stg + row * 64 + ch * 8);
          const h16x8 g = *(const h16x8*)(GA + (orow0 + row) * KP + h * 64 + ch * 8); h16x8 w;
#pragma unroll
          for (int e = 0; e < 8; ++e) w[e] = (h16)((float)v[e] * siluf_((float)g[e]));
          *(h16x8*)(MIX + (orow0 + row) * OP + h * 64 + ch * 8) = w; } }
    asm volatile("s_waitcnt vmcnt(0) lgkmcnt(0)\n\ts_barrier" ::: "memory");
#undef DMA_K
#undef DMA_V
#undef CMASK
#undef START
#undef RESC
#undef ROT
#undef QBF
#undef QBIAS
#undef DMA_R
#undef KBREAD
}
#undef SBAR
#undef WAIT_BAR_KB
}
__device__ __forceinline__ float skip_thr(const float* gq, const float* gk);
__device__ __forceinline__ void attn_sample_wave(const Ctx& C, int sb, int h, char* wl);
__device__ __forceinline__ void ssm_carry_thread(const Ctx& C, int gt);
__device__ __forceinline__ void attn_prompt_phase(const Ctx& C, unsigned char* lds, int qoff) {
    char* shm = (char*)lds;
    volatile int* info = (volatile int*)(shm + attn::LDS_INFO);
    for (;;) {
        if (C.tid == 0) info[1] = (int)__hip_atomic_fetch_add(C.ctl + CW_Q + qoff, 1u, __ATOMIC_RELAXED, __HIP_MEMORY_SCOPE_AGENT);
        __syncthreads();
        const int idx = __builtin_amdgcn_readfirstlane(info[1]);
        __syncthreads();
        if (idx >= 40) break;
        if (idx < 32) attn_sample_wave(C, idx, C.wave, shm + C.wave * 5376);
        else ssm_carry_thread(C, (idx - 32) * NTHREADS + C.tid);
    }
    const float thr = skip_thr(C.gq, C.gk);
    for (;;) {
        if (C.tid == 0) info[1] = (int)__hip_atomic_fetch_add(C.ctl + CW_Q + 64 + qoff, 1u, __ATOMIC_RELAXED, __HIP_MEMORY_SCOPE_AGENT);
        __syncthreads();
        const int idx = __builtin_amdgcn_readfirstlane(info[1]);
        __syncthreads();
        if (idx >= 16 * 64) break;
        const int qb = 64 - idx / 16, bh = idx % 16;
        attn::attn_unit<8>(bh >> 3, bh & 7, qb, C.Q16, C.K16, C.V16, C.GA, C.MIX, C.ANCH + bh * 264, C.KBT + (size_t)bh * 260 * 1024, C.NEG1, thr, shm);
    }
}

__device__ __forceinline__ float skip_thr(const float* gq, const float* gk) {
    float a = 0.f, b = 0.f;
    for (int d = 0; d < 64; ++d) { a = fmaxf(a, fabsf(gq[d])); b = fmaxf(b, fabsf(gk[d])); }
    return 104.0f + 2.0f * 8.0f * a * b + 1.0f;
}
__device__ __forceinline__ void attn_sample_wave(const Ctx& C, int sb, int h, char* wl) {
    int lane_ = C.lane; asm volatile("" : "+v"(lane_));
    const int lane = lane_, c16 = lane & 15, g = lane >> 4;
    float* dk = (float*)wl; float* pt = dk + 1040; float* sc = pt + 256;
    constexpr double L2E = 1.4426950408889634;
    const double* cs = C.CUMS + (size_t)sb * (PAST + DS) * 8 + h;
    const double ref = cs[(size_t)(PAST - 1) * 8];
    for (int k = lane; k < PAST + DS; k += 64) dk[k] = (float)((ref - cs[(size_t)k * 8]) * L2E);
    const float dq = (float)((cs[(size_t)(PAST + c16) * 8] - ref) * L2E);
    const size_t Rq = (size_t)MP + (size_t)sb * DS;
    const h16* qp = C.Q16 + (Rq + c16) * 512 + h * 64 + 8 * g;
    const h16x8 qf0 = *(const h16x8*)qp, qf1 = *(const h16x8*)(qp + 32);
    float m_run = -INFINITY, l_run = 0.f, o[16];
#pragma unroll
    for (int i = 0; i < 16; ++i) o[i] = 0.f;
    LDS_WAIT();
#define SAMPLE_TILE(KA0, KA1, VR, t, LAST) do { \
        f32x4 s_ = __builtin_amdgcn_mfma_f32_16x16x32_f16(KA0, qf0, (f32x4){0.f, 0.f, 0.f, 0.f}, 0, 0, 0); s_ = __builtin_amdgcn_mfma_f32_16x16x32_f16(KA1, qf1, s_, 0, 0, 0); \
        float tm_ = -INFINITY; \
        _Pragma("unroll") for (int i = 0; i < 4; ++i) { s_[i] += dq + dk[16 * (t) + 4 * g + i]; if ((LAST) && 4 * g + i > c16) s_[i] = -INFINITY; tm_ = fmaxf(tm_, s_[i]); } \
        tm_ = fmaxf(tm_, __shfl_xor(tm_, 16)); tm_ = fmaxf(tm_, __shfl_xor(tm_, 32)); \
        const float mn_ = fmaxf(m_run, tm_), scale_ = __builtin_amdgcn_exp2f(m_run - mn_); m_run = mn_; \
        float ps_ = 0.f; \
        _Pragma("unroll") for (int i = 0; i < 4; ++i) { const float p_ = __builtin_amdgcn_exp2f(s_[i] - mn_); ps_ += p_; pt[(4 * g + i) * 16 + c16] = p_; } \
        l_run = l_run * scale_ + ps_; \
        if (g == 0) sc[c16] = scale_; \
        LDS_WAIT(); \
        { const f32x4 s0_ = *(const f32x4*)&sc[0], s1_ = *(const f32x4*)&sc[4], s2_ = *(const f32x4*)&sc[8], s3_ = *(const f32x4*)&sc[12]; \
          _Pragma("unroll") for (int i = 0; i < 4; ++i) { o[i] *= s0_[i]; o[4 + i] *= s1_[i]; o[8 + i] *= s2_[i]; o[12 + i] *= s3_[i]; } } \
        _Pragma("unroll") for (int kk = 0; kk < 16; ++kk) { \
            const f32x4 p0_ = *(const f32x4*)&pt[kk * 16], p1_ = *(const f32x4*)&pt[kk * 16 + 4], p2_ = *(const f32x4*)&pt[kk * 16 + 8], p3_ = *(const f32x4*)&pt[kk * 16 + 12]; const float v_ = VR[kk]; \
            _Pragma("unroll") for (int i = 0; i < 4; ++i) { o[i] += p0_[i] * v_; o[4 + i] += p1_[i] * v_; o[8 + i] += p2_[i] * v_; o[12 + i] += p3_[i] * v_; } \
            if ((kk & 1) == 1) { asm volatile("" : "+v"(o[0]), "+v"(o[1]), "+v"(o[2]), "+v"(o[3]), "+v"(o[4]), "+v"(o[5]), "+v"(o[6]), "+v"(o[7]), "+v"(o[8]), "+v"(o[9]), "+v"(o[10]), "+v"(o[11]), "+v"(o[12]), "+v"(o[13]), "+v"(o[14]), "+v"(o[15])); __builtin_amdgcn_sched_barrier(0); } } \
        LDS_WAIT(); } while (0)
    const unsigned cbytes = (unsigned)((PAST * NH - h) * HD * 4);
    const __amdgpu_buffer_rsrc_t rk = __builtin_amdgcn_make_buffer_rsrc((void*)(C.ck + ((size_t)sb * PAST * NH + h) * HD), 0, cbytes, 0x00020000);
    const __amdgpu_buffer_rsrc_t rv = __builtin_amdgcn_make_buffer_rsrc((void*)(C.cv + ((size_t)sb * PAST * NH + h) * HD), 0, cbytes, 0x00020000);
    const __amdgpu_buffer_rsrc_t rk16 = __builtin_amdgcn_make_buffer_rsrc((void*)(C.K16 + Rq * 512 + h * 64), 0, 16 * 512 * 2, 0x00020000);
    const __amdgpu_buffer_rsrc_t rv16 = __builtin_amdgcn_make_buffer_rsrc((void*)(C.V16 + Rq * 512 + h * 64), 0, 16 * 512 * 2, 0x00020000);
    const unsigned kvo = (unsigned)((c16 * NH * HD + 8 * g) * 4), kvo16 = (unsigned)((c16 * 512 + 8 * g) * 2);
    typedef unsigned u32x4_t __attribute__((ext_vector_type(4)));
    float4 kr[4]; float vr[16];
#define SAMPLE_LOADK(KR, t) do { if ((t) < PAST / 16) { const unsigned so_ = (unsigned)(t) * (16u * NH * HD * 4u); \
            KR[0] = __builtin_bit_cast(float4, __builtin_amdgcn_raw_buffer_load_b128(rk, kvo, so_, 0)); KR[1] = __builtin_bit_cast(float4, __builtin_amdgcn_raw_buffer_load_b128(rk, kvo + 16, so_, 0)); \
            KR[2] = __builtin_bit_cast(float4, __builtin_amdgcn_raw_buffer_load_b128(rk, kvo + 128, so_, 0)); KR[3] = __builtin_bit_cast(float4, __builtin_amdgcn_raw_buffer_load_b128(rk, kvo + 144, so_, 0)); } \
        else { const h16x8 a_ = __builtin_bit_cast(h16x8, __builtin_amdgcn_raw_buffer_load_b128(rk16, kvo16, 0, 0)), b_ = __builtin_bit_cast(h16x8, __builtin_amdgcn_raw_buffer_load_b128(rk16, kvo16 + 64, 0, 0)); \
            KR[0] = make_float4((float)a_[0], (float)a_[1], (float)a_[2], (float)a_[3]); KR[1] = make_float4((float)a_[4], (float)a_[5], (float)a_[6], (float)a_[7]); \
            KR[2] = make_float4((float)b_[0], (float)b_[1], (float)b_[2], (float)b_[3]); KR[3] = make_float4((float)b_[4], (float)b_[5], (float)b_[6], (float)b_[7]); } } while (0)
#define SAMPLE_LOADV(VR, t) do { if ((t) < PAST / 16) { const unsigned so_ = (unsigned)(t) * (16u * NH * HD * 4u); \
            _Pragma("unroll") for (int kk = 0; kk < 16; ++kk) VR[kk] = __builtin_bit_cast(float, __builtin_amdgcn_raw_buffer_load_b32(rv, lane * 4, so_ + kk * (NH * HD * 4), 0)); } \
        else { _Pragma("unroll") for (int kk = 0; kk < 16; ++kk) VR[kk] = (float)__builtin_bit_cast(h16, __builtin_amdgcn_raw_buffer_load_b16(rv16, lane * 2, kk * 1024, 0)); } } while (0)
    SAMPLE_LOADK(kr, 0); SAMPLE_LOADV(vr, 0);
#pragma clang loop unroll(disable)
    for (int t = 0; t <= PAST / 16; ++t) {
        const h16x8 ka0 = {(h16)kr[0].x, (h16)kr[0].y, (h16)kr[0].z, (h16)kr[0].w, (h16)kr[1].x, (h16)kr[1].y, (h16)kr[1].z, (h16)kr[1].w};
        const h16x8 ka1 = {(h16)kr[2].x, (h16)kr[2].y, (h16)kr[2].z, (h16)kr[2].w, (h16)kr[3].x, (h16)kr[3].y, (h16)kr[3].z, (h16)kr[3].w};
        __builtin_amdgcn_sched_barrier(0);
        if (t < PAST / 16) SAMPLE_LOADK(kr, t + 1);
        __builtin_amdgcn_sched_barrier(0);
        SAMPLE_TILE(ka0, ka1, vr, t, (t == PAST / 16));
        __builtin_amdgcn_sched_barrier(0);
        if (t < PAST / 16) SAMPLE_LOADV(vr, t + 1);
        __builtin_amdgcn_sched_barrier(0);
    }
#undef SAMPLE_TILE
#undef SAMPLE_LOADK
#undef SAMPLE_LOADV
    float l = l_run; l += __shfl_xor(l, 16); l += __shfl_xor(l, 32);
    if (g == 0) sc[c16] = __builtin_amdgcn_rcpf(l);
    LDS_WAIT();
#pragma unroll
    for (int q2 = 0; q2 < 16; ++q2) dk[q2 * 64 + lane] = o[q2] * sc[q2];
    LDS_WAIT();
#pragma clang loop unroll(disable)
    for (int q2 = 0; q2 < 16; ++q2) { const float ga = (float)C.GA[(Rq + q2) * 512 + h * 64 + lane]; C.MIX[(Rq + q2) * 1024 + h * 64 + lane] = (h16)(dk[q2 * 64 + lane] * siluf_(ga)); }
    LDS_WAIT();
}

__device__ __forceinline__ void ssm_tables_b(const Ctx& C, bool doT1, bool doT2) {
    const int gt = C.gw * 64 + C.lane, NT_ = C.NGW * 64;
  if (doT1) {
    for (int it = gt; it < NG * 32 * 8 * 64; it += NT_) {
        const int lane = it & 63, nb = (it >> 6) & 7, kk = (it >> 9) & 31, g = it >> 14, kq = lane >> 4;
        const int s = 2 * kk + (kq >> 1), h0 = 8 * (kq & 1), pp = 16 * nb + (lane & 15), p = pp >> 1, part = pp & 1;
        const float2 pw = C.POW[((size_t)g * 65 + (63 - s)) * NST + p]; const float inv = 1.0f / C.WSC[g];
        h16x8 o;
#pragma unroll
        for (int j = 0; j < 8; ++j) { const float2 bb = C.BBAR[(g * 64 + p) * 16 + h0 + j]; o[j] = (h16)(inv * (part ? pw.x * bb.y + pw.y * bb.x : pw.x * bb.x - pw.y * bb.y)); }
        *(h16x8*)(C.T1 + (size_t)it * 8) = o;
    }
  }
  if (doT2) {
    for (int it = gt; it < NG * 32 * 64; it += NT_) {
        const int lane = it & 63, kk = (it >> 6) & 31, g = it >> 11, kq = lane >> 4, lag = 2 * kk + (kq >> 1), h0 = 8 * (kq & 1), hp = lane & 15;
        float acc[8];
#pragma unroll
        for (int j = 0; j < 8; ++j) acc[j] = 0.f;
#pragma clang loop unroll_count(4)
        for (int p = 0; p < NST; ++p) {
            const float2 pw = C.POW[((size_t)g * 65 + lag) * NST + p]; const float cr = C.cre[((size_t)g * 16 + hp) * 64 + p], ci = C.cim[((size_t)g * 16 + hp) * 64 + p];
            const float er = cr * pw.x - ci * pw.y, ei = cr * pw.y + ci * pw.x;
#pragma unroll
            for (int j = 0; j < 8; ++j) { const float2 bb = C.BBAR[(g * 64 + p) * 16 + h0 + j]; acc[j] += er * bb.x - ei * bb.y; }
        }
        const float inv = 1.0f / C.WSC[g]; h16x8 o;
#pragma unroll
        for (int j = 0; j < 8; ++j) o[j] = (h16)(acc[j] * inv);
        *(h16x8*)(C.T2 + (size_t)it * 8) = o;
    }
  }
  if (doT1) {
    for (int it = gt; it < NG * 4 * 64; it += NT_) {
        const int lane = it & 63, kk = (it >> 6) & 3, g = it >> 8, kq = lane >> 4, hp = lane & 15;
        h16x8 o;
#pragma unroll
        for (int j = 0; j < 8; ++j) { const int pp = 32 * kk + 8 * kq + j, p = pp >> 1; o[j] = (h16)((pp & 1) ? -C.cim[((size_t)g * 16 + hp) * 64 + p] : C.cre[((size_t)g * 16 + hp) * 64 + p]); }
        *(h16x8*)(C.CMF + (size_t)it * 8) = o;
    }
  }
}
__device__ __forceinline__ void ssm_send_item(const Ctx& C, int item) {
    int lane_ = C.lane; asm volatile("" : "+v"(lane_));
    const int lane = lane_, r16 = lane & 15, kq = lane >> 4, g = item & 31, cb = item >> 5;
    const bool samp = cb >= 33;
    f32x4 acc[8];
#pragma unroll
    for (int nb = 0; nb < 8; ++nb) acc[nb] = (f32x4){0.f, 0.f, 0.f, 0.f};
    const int cg = cb * 16 + r16; const bool valid = samp || cg < NB * NCH;
    const h16* arow = samp ? C.U + ((size_t)MP + (size_t)((cb - 33) * 16 + r16) * DS) * 512 + g * 16 + 8 * (kq & 1) - (size_t)48 * 512
                           : C.U + (size_t)(valid ? cg : 0) * 64 * 512 + g * 16 + 8 * (kq & 1);
    const h16* t1 = C.T1 + (size_t)g * (32 * 8 * 64 * 8) + lane * 8;
#pragma clang loop unroll_count(2)
    for (int kk = 0; kk < 32; ++kk) {
        const int s = 2 * kk + (kq >> 1);
        h16x8 a = {0, 0, 0, 0, 0, 0, 0, 0};
        if (valid && (!samp || s >= 48)) a = *(const h16x8*)(arow + (size_t)s * 512);
#pragma unroll
        for (int nb = 0; nb < 8; ++nb) { const h16x8 b = *(const h16x8*)(t1 + (size_t)(kk * 8 + nb) * 512); acc[nb] = __builtin_amdgcn_mfma_f32_16x16x32_f16(a, b, acc[nb], 0, 0, 0); }
    }
    const float ws = C.WSC[g];
#pragma unroll
    for (int nb = 0; nb < 8; ++nb)
#pragma unroll
        for (int e = 0; e < 4; ++e) {
            const int pp = 16 * nb + r16; const float v = acc[nb][e] * ws;
            if (!samp) { const int c = cb * 16 + 4 * kq + e; if (c < NB * NCH) ((float*)C.SEND)[((size_t)c * NG + g) * 128 + pp] = v; }
            else { const int sbi = (cb - 33) * 16 + 4 * kq + e, p = pp >> 1; const size_t si = ((size_t)sbi * NG + g) * NST + p;
                const float x0r = C.sre[si], x0i = C.sim[si]; const float2 a16 = C.ABAR[2 * NG * NST + g * 64 + p];
                if (pp & 1) C.out[O_SIS + si] = v + a16.x * x0i + a16.y * x0r; else C.out[O_SRS + si] = v + a16.x * x0r - a16.y * x0i; }
        }
}
__device__ __forceinline__ void ssm_carry_thread(const Ctx& C, int gt) {
    const int b = gt >> 11, gp = gt & 2047;
    const float2 a = C.ABAR[NG * NST + gp];
    float xr = 0.f, xi = 0.f;
    static_assert(NCH % 26 == 0, "carry scan batches");
#pragma clang loop unroll(disable)
    for (int c0 = 0; c0 < NCH; c0 += 26) {
        float2 s[26];
#pragma unroll
        for (int j = 0; j < 26; ++j) s[j] = C.SEND[((size_t)(b * NCH + c0 + j)) * (NG * NST) + gp];
#pragma unroll
        for (int j = 0; j < 26; ++j) {
            C.XST[((size_t)(b * NCH + c0 + j)) * (NG * NST) + gp] = make_float2(xr, xi);
            const float nr = a.x * xr - a.y * xi + s[j].x, ni = a.x * xi + a.y * xr + s[j].y; xr = nr; xi = ni;
        }
    }
    C.out[O_SRP + (size_t)b * NG * NST + gp] = xr; C.out[O_SIP + (size_t)b * NG * NST + gp] = xi;
}
__device__ __forceinline__ void ssm_out_wg(const Ctx& C, unsigned char* lds) {
    int lane_ = C.lane; asm volatile("" : "+v"(lane_));
    const int lane = lane_, r16 = lane & 15, kq = lane >> 4;
  for (int vw = C.vcu; vw < 256; vw += C.G) {
    const int g = vw & 31, part = vw >> 5;
    __syncthreads();
    { const uint4* s2 = (const uint4*)(C.T2 + (size_t)g * (32 * 64 * 8)); const uint4* sc = (const uint4*)(C.CMF + (size_t)g * (4 * 64 * 8)); uint4* d = (uint4*)lds;
      for (int i = C.tid; i < 2048 + 256; i += NTHREADS) d[i] = i < 2048 ? s2[i] : sc[i - 2048];
      const uint4* sp = (const uint4*)(C.POW + ((size_t)g * 65 + 1) * NST); uint4* dp = (uint4*)(lds + 69632);
      for (int i = C.tid; i < 2048; i += NTHREADS) dp[i] = sp[i]; }
    h16* ut = (h16*)(lds + 36864 + C.wave * 4096);
    *(uint4*)(ut + lane * 16) = make_uint4(0u, 0u, 0u, 0u); *(uint4*)(ut + lane * 16 + 8) = make_uint4(0u, 0u, 0u, 0u);
    __syncthreads();
    const LAS char* t2l = (const LAS char*)lds + lane * 16; const LAS char* cml = (const LAS char*)lds + 32768 + lane * 16;
    const float ws = C.WSC[g], dcoef = C.dd[g * 16 + r16];
    for (int it = C.wave; it < 65 + 4; it += NWAVES) {
        const bool samp = it >= 65;
        const int cg = it * 8 + part, sb = (it - 65) * 8 + part;
        if (!samp && (cg % NCH) < 4) continue;
        const long rowbase = samp ? (long)MP + (long)sb * DS - 48 : (long)cg * 64; const int pad = samp ? 48 : 0;
        { uint4 u0 = make_uint4(0u, 0u, 0u, 0u), u1 = u0;
          if (!samp || lane >= 48) { const uint4* up = (const uint4*)(C.U + (rowbase + lane) * 512 + g * 16); u0 = up[0]; u1 = up[1]; }
          *(uint4*)(ut + (64 + lane) * 16) = u0; *(uint4*)(ut + (64 + lane) * 16 + 8) = u1; }
        float4 x0v[8];
#pragma unroll
        for (int kk = 0; kk < 4; ++kk) { const int p0 = 16 * kk + 4 * kq;
            if (samp) { const size_t si = ((size_t)sb * NG + g) * NST + p0; const float4 re = *(const float4*)(C.sre + si), im = *(const float4*)(C.sim + si);
                x0v[2 * kk] = make_float4(re.x, im.x, re.y, im.y); x0v[2 * kk + 1] = make_float4(re.z, im.z, re.w, im.w); }
            else { const float4* xp = (const float4*)(C.XST + ((size_t)cg * NG + g) * NST + p0); x0v[2 * kk] = xp[0]; x0v[2 * kk + 1] = xp[1]; } }
        const float4* powl = (const float4*)(lds + 69632);
        LDS_WAIT();
#pragma clang loop unroll(disable)
        for (int r = 0; r < 4; ++r) {
            const int t = 16 * r + r16; int pn = t + 1 - pad; pn = pn < 0 ? 0 : pn;
            f32x4 accC = {0.f, 0.f, 0.f, 0.f}, accT = {0.f, 0.f, 0.f, 0.f};
#pragma unroll
            for (int kk = 0; kk < 4; ++kk) {
                const int p0 = 16 * kk + 4 * kq; const float4* pw = powl + ((pn < 1 ? 1 : pn) - 1) * 32 + (p0 >> 1);
                const float4 w0 = pw[0], w1 = pw[1], xa0 = x0v[2 * kk], xa1 = x0v[2 * kk + 1];
                h16x8 xa;
                xa[0] = (h16)(w0.x * xa0.x - w0.y * xa0.y); xa[1] = (h16)(w0.x * xa0.y + w0.y * xa0.x); xa[2] = (h16)(w0.z * xa0.z - w0.w * xa0.w); xa[3] = (h16)(w0.z * xa0.w + w0.w * xa0.z);
                xa[4] = (h16)(w1.x * xa1.x - w1.y * xa1.y); xa[5] = (h16)(w1.x * xa1.y + w1.y * xa1.x); xa[6] = (h16)(w1.z * xa1.z - w1.w * xa1.w); xa[7] = (h16)(w1.z * xa1.w + w1.w * xa1.z);
                accC = __builtin_amdgcn_mfma_f32_16x16x32_f16(xa, *(const LAS h16x8*)(cml + kk * 1024), accC, 0, 0, 0);
            }
#pragma clang loop unroll_count(4)
            for (int kk = 0; kk < 8 * (r + 1); ++kk) {
                const h16x8 a = *(const h16x8*)(ut + (64 + t - 2 * kk - (kq >> 1)) * 16 + 8 * (kq & 1));
                accT = __builtin_amdgcn_mfma_f32_16x16x32_f16(a, *(const LAS h16x8*)(t2l + kk * 1024), accT, 0, 0, 0);
            }
#pragma unroll
            for (int e = 0; e < 4; ++e) {
                const int te = 16 * r + 4 * kq + e;
                const float u = (float)ut[(64 + te) * 16 + r16];
                const float y = accC[e] + ws * accT[e] + dcoef * u;
                const float z = y * sigmoidf_(1.5957691216057308f * (y + 0.044715f * y * y * y));
                if (!samp || te >= 48) C.Z[(rowbase + te) * 512 + g * 16 + r16] = (h16)z;
            }
        }
        LDS_WAIT();
    }
  }
}

__global__ void __launch_bounds__(NTHREADS, 2) mk_fwd(Args args) {
    extern __shared__ __attribute__((aligned(16))) unsigned char lds[];
    Ctx C;
    C.tid = threadIdx.x; C.lane = C.tid & 63; C.wave = __builtin_amdgcn_readfirstlane(C.tid >> 6);
    C.G = gridDim.x; { const int bx = blockIdx.x; C.vcu = (C.G % 8 == 0) ? (bx % 8) * (C.G / 8) + bx / 8 : bx; }
    C.gw = C.vcu * NWAVES + C.wave; C.NGW = C.G * NWAVES;
    C.xp = args.in[0]; C.xs = args.in[1]; C.ck = args.in[2]; C.cv = args.in[3]; C.clf = args.in[4]; C.sre = args.in[5]; C.sim = args.in[6]; C.meta = args.in[7];
    C.ng = args.in[8]; C.win = args.in[9]; C.bf = args.in[10]; C.gq = args.in[11]; C.gk = args.in[12]; C.are = args.in[13]; C.aim = args.in[14]; C.ldt = args.in[15];
    C.bre = args.in[16]; C.bim = args.in[17]; C.cre = args.in[18]; C.cim = args.in[19]; C.dd = args.in[20]; C.wglu = args.in[21]; C.bglu = args.in[22]; C.wout = args.in[23];
    C.out = args.out; unsigned char* ws = args.ws;
    C.WINT = (h16*)(ws + WS_WINT); C.WGLUT = (h16*)(ws + WS_WGLUT); C.WOUTT = (h16*)(ws + WS_WOUTT); C.XN = (h16*)(ws + WS_XN);
    C.LOGF = (float*)(ws + WS_LOGF); C.CUM = (double*)(ws + WS_CUM); C.CUMS = (double*)(ws + WS_CUMS); C.Q16 = (h16*)(ws + WS_Q); C.K16 = (h16*)(ws + WS_K); C.V16 = (h16*)(ws + WS_V);
    C.GA = (h16*)(ws + WS_GA); C.U = (h16*)(ws + WS_U); C.GS = (h16*)(ws + WS_GS); C.Z = (h16*)(ws + WS_Z); C.MIX = (h16*)(ws + WS_MIX);
    C.ABAR = (float2*)(ws + WS_ABAR); C.BBAR = (float2*)(ws + WS_BBAR); C.SEND = (float2*)(ws + WS_SEND); C.XST = (float2*)(ws + WS_XST);
    C.ANCH = (double*)(ws + WS_ANCH); C.KBT = (char*)(ws + WS_KBT); C.NEG1 = (char*)(ws + WS_NEG1); C.ctl = (unsigned*)(ws + WS_CTL);
    C.POW = (float2*)(ws + WS_POW); C.WSC = (float*)(ws + WS_WSC); C.T1 = (h16*)(ws + WS_T1); C.T2 = (h16*)(ws + WS_T2); C.CMF = (h16*)(ws + WS_CMF);

    for (int u = C.tid; u < (LDS_BYTES - LDSCTL_OFF) / 4; u += NTHREADS) ((LAS unsigned*)((LAS unsigned char*)lds + LDSCTL_OFF))[u] = 0u;
    __syncthreads();
    XcdBarrier bar = xcd_barrier_post((unsigned*)(ws + WS_CTL) + CW_BAR, (volatile LAS unsigned*)((LAS unsigned char*)lds + MISC_OFF) + 8);

#ifndef RPH
#define RPH -1
#endif
#define REP(k) for (int rep_ = 0; rep_ < ((RPH) == (k) ? 2 : 1); ++rep_)
    REP(0) {
    phase0(C, lds);
    xcd_barrier(bar); }
    REP(1) {
    { const int bx = (int)blockIdx.x;
      if (C.G >= 128) { if (bx >= 64 && bx < 64 + NB * NH) cum_prompt_wg(C, lds, (bx - 64) >> 3, (bx - 64) & 7);
                        if (bx >= 96 && bx < 128) cum_sample_wave(C, (bx - 96) * NWAVES + C.wave); }
      else { for (int j = bx; j < NB * NH; j += C.G) cum_prompt_wg(C, lds, j >> 3, j & 7); for (int it = C.gw; it < DB * NH; it += C.NGW) cum_sample_wave(C, it); } }
    ssm_tables_b(C, true, false);
    { pg8::Gemm g{C.XN, C.WINT, MT, 3072, 1024}; pg8::StaticOrder S; S.init(MT, 3072, C.G, (int)blockIdx.x);
      EpiInProj E{C.Q16, C.out, C.gq, C.gk};
      pg8::gemm_phase<EpiInProj, pg8::StaticOrder, true, true>((PG8_LAS unsigned char*)lds, g, S, E); }
    xcd_barrier(bar); }
    REP(2) {
    for (int it = C.gw; it < 35 * NG; it += C.NGW) ssm_send_item(C, it);
    ssm_tables_b(C, false, true);
    xcd_barrier(bar); }
    REP(3) {
    attn_prompt_phase(C, lds, rep_ * 128);
    xcd_barrier(bar); }
    REP(4) {
    ssm_out_wg(C, lds);
    xcd_barrier(bar); }
    REP(5) {
    { pg8::Gemm g{C.Z, C.WGLUT, MT, 512, 512}; OutOrder S; S.init(130 * 256, 512, C.G, (int)blockIdx.x);
      EpiGluT E{C.Z, C.GS, C.bglu, C.MIX};
      pg8::gemm_phase<EpiGluT, OutOrder, true, true>((PG8_LAS unsigned char*)lds, g, S, E); }
    xcd_barrier(bar); }
    REP(6) {
    { pg8::Gemm g{C.MIX, C.WOUTT, MT, 1024, 1024}; OutOrder S; S.init(130 * 256, 1024, C.G, (int)blockIdx.x);
      EpiOutT E{C.xp, C.xs, C.out};
      pg8::gemm_phase<EpiOutT, OutOrder, true, true>((PG8_LAS unsigned char*)lds, g, S, E); }
    if ((RPH) == 6) xcd_barrier(bar); }
}

extern "C" void kernel_launch(void* const* d_in, const int* in_sizes, int n_in, void* d_out, int out_size, void* d_ws, size_t ws_size, hipStream_t stream) {
    static int grid = 0;
    if (grid == 0) {
        if (n_in != 24 || (size_t)out_size != O_END || ws_size < WS_END) { fprintf(stderr, "kernel_launch: unexpected sizes n_in %d out %d ws %zu (need %zu)\n", n_in, out_size, ws_size, (size_t)WS_END); grid = -1; return; }
        int dev = 0, cus = 0, per_cu = 0;
        if (hipGetDevice(&dev) != hipSuccess || hipDeviceGetAttribute(&cus, hipDeviceAttributeMultiprocessorCount, dev) != hipSuccess) { grid = -1; return; }
        if (hipFuncSetAttribute((const void*)mk_fwd, hipFuncAttributeMaxDynamicSharedMemorySize, LDS_BYTES) != hipSuccess) { fprintf(stderr, "kernel_launch: hipFuncSetAttribute failed\n"); grid = -1; return; }
        if (hipOccupancyMaxActiveBlocksPerMultiprocessor(&per_cu, (const void*)mk_fwd, NTHREADS, LDS_BYTES) != hipSuccess || per_cu < 1) { fprintf(stderr, "kernel_launch: occupancy query says %d blocks per CU\n", per_cu); grid = -1; (void)hipGetLastError(); return; }
        grid = cus;
    }
    if (grid < 0) return;
    if (hipMemsetAsync((char*)d_ws + WS_CTL, 0, CTL_ZERO_BYTES, stream) != hipSuccess) return;
    Args a{};
    for (int i = 0; i < 24; ++i) a.in[i] = (const float*)d_in[i];
    a.out = (float*)d_out; a.ws = (unsigned char*)d_ws;
    hipLaunchKernelGGL(mk_fwd, dim3(grid), dim3(NTHREADS), LDS_BYTES, stream, a);
}
```
